# Optimizing an MI355X kernel written in HIP

```python
import jax
import jax.numpy as jnp
from jax import lax
import numpy as np

D_MODEL = 1024
BATCH = 2
SEQ = 8192
DEPTH = 2

CHUNK = 64
D_FF = 2816
D_CONV = 512
CONV_WIDTH = 31
GLA_HEADS = 4
GLA_DK = 64
GLA_DV = 128
D_GLA = GLA_HEADS * GLA_DV
D_MIX = D_CONV + D_GLA
GATE_RANK = 16
GATE_TAU = 16.0
N_MOD = 9
EPS = 1e-6
SPLITS = (D_CONV, 2 * D_CONV, 2 * D_CONV + GLA_HEADS * GLA_DK, 2 * D_CONV + 2 * GLA_HEADS * GLA_DK, 2 * D_CONV + 2 * GLA_HEADS * GLA_DK + D_GLA, 2 * D_CONV + 2 * GLA_HEADS * GLA_DK + 2 * D_GLA)
D_IN = SPLITS[-1] + GATE_RANK

kernel_name = 'hybrid_conformer_gla_macaron'


def rmsnorm(x, g):
    xf = x.astype(jnp.float32)
    y = xf * lax.rsqrt(jnp.mean(xf * xf, axis=-1, keepdims=True) + EPS)
    return (y * g.astype(jnp.float32)).astype(x.dtype)


def layernorm(x, g, b):
    xf = x.astype(jnp.float32)
    xc = xf - jnp.mean(xf, axis=-1, keepdims=True)
    y = xc * lax.rsqrt(jnp.mean(xc * xc, axis=-1, keepdims=True) + EPS)
    return (y * g.astype(jnp.float32) + b.astype(jnp.float32)).astype(x.dtype)


def modulate(h, shift, scale):
    return h * (1 + scale) + shift


def swiglu(h, w_in, w_out):
    gate, up = jnp.split(h @ w_in, 2, axis=-1)
    return (jax.nn.silu(gate) * up) @ w_out


def conformer_conv(a, b, w_dw, b_dw, g_ln, b_ln):
    u = a * jax.nn.sigmoid(b)
    u = jnp.pad(u, ((0, 0), (CONV_WIDTH - 1, 0), (0, 0)))
    y = lax.conv_general_dilated(u, w_dw.astype(u.dtype)[:, None, :], window_strides=(1,), padding='VALID', dimension_numbers=('NWC', 'WIO', 'NWC'), feature_group_count=D_CONV)
    return jax.nn.silu(layernorm(y + b_dw, g_ln, b_ln))


def gla(q, k, v, r, glr, w_gate_up, b_gate, g_norm):
    bsz, seq, _ = q.shape
    n = seq // CHUNK
    f32 = jnp.float32

    def heads(t, d):
        return t.astype(f32).reshape(bsz, n, CHUNK, GLA_HEADS, d).transpose(0, 3, 1, 2, 4)

    log_a = jax.nn.log_sigmoid((glr @ w_gate_up + b_gate).astype(f32)) / GATE_TAU
    qh = heads(q, GLA_DK) * (GLA_DK ** -0.5)
    kh = heads(k, GLA_DK)
    vh = heads(v, GLA_DV)
    bc = jnp.cumsum(heads(log_a, GLA_DK), axis=3)
    b_end = bc[:, :, :, -1:, :]
    q_fwd = qh * jnp.exp(bc)
    att_fwd = jnp.einsum('bhnik,bhnjk->bhnij', q_fwd, kh * jnp.exp(-bc))
    att_bwd = jnp.einsum('bhnik,bhnjk->bhnij', qh * jnp.exp(-bc), kh * jnp.exp(bc))
    tri = jnp.tril(jnp.ones((CHUNK, CHUNK), dtype=bool))
    o = jnp.einsum('bhnij,bhnjv->bhniv', jnp.where(tri, att_fwd, att_bwd), vh)
    u = jnp.einsum('bhnjk,bhnjv->bhnkv', kh * jnp.exp(b_end - bc), vh)
    g = jnp.exp(b_end[:, :, :, 0, :])

    def step(state, inp):
        g_c, u_c = inp
        return g_c[..., None] * state + u_c, state

    s0 = jnp.zeros((bsz, GLA_HEADS, GLA_DK, GLA_DV), f32)
    _, s_prev = lax.scan(step, s0, (jnp.moveaxis(g, 2, 0), jnp.moveaxis(u, 2, 0)))
    o = o + jnp.einsum('bhnik,nbhkv->bhniv', q_fwd, s_prev)
    o = o * lax.rsqrt(jnp.mean(o * o, axis=-1, keepdims=True) + EPS) * g_norm.astype(f32)[:, None, None, :]
    o = o.transpose(0, 2, 3, 1, 4).reshape(bsz, seq, D_GLA)
    return (o * jax.nn.silu(r.astype(f32))).astype(q.dtype)


def setup_inputs(seed: int = 0) -> dict:
    key = jax.random.key(seed)
    ks = jax.random.split(key, 26)
    L = DEPTH

    def nrm(k, shape, scale):
        return jax.random.normal(k, shape, jnp.float32) * scale

    return {
        'x': nrm(ks[0], (BATCH, SEQ, D_MODEL), 1.0),
        'c': nrm(ks[1], (BATCH, D_MODEL), 1.0),
        'w_ada': nrm(ks[2], (L, D_MODEL, N_MOD * D_MODEL), 0.5 * D_MODEL ** -0.5),
        'b_ada': nrm(ks[3], (L, N_MOD * D_MODEL), 0.02),
        'g_norm_ffn1': 1.0 + nrm(ks[4], (L, D_MODEL), 0.02),
        'w_ffn1_in': nrm(ks[5], (L, D_MODEL, 2 * D_FF), D_MODEL ** -0.5),
        'w_ffn1_out': nrm(ks[6], (L, D_FF, D_MODEL), D_FF ** -0.5),
        'g_norm_mix': 1.0 + nrm(ks[7], (L, D_MODEL), 0.02),
        'w_in': nrm(ks[8], (L, D_MODEL, D_IN), D_MODEL ** -0.5),
        'w_dw': nrm(ks[9], (L, CONV_WIDTH, D_CONV), CONV_WIDTH ** -0.5),
        'b_dw': nrm(ks[10], (L, D_CONV), 0.02),
        'g_conv_ln': 1.0 + nrm(ks[11], (L, D_CONV), 0.02),
        'b_conv_ln': nrm(ks[12], (L, D_CONV), 0.02),
        'w_gate_up': nrm(ks[13], (L, GATE_RANK, GLA_HEADS * GLA_DK), GATE_RANK ** -0.5),
        'b_gate': nrm(ks[14], (L, GLA_HEADS * GLA_DK), 0.02),
        'g_gla_norm': 1.0 + nrm(ks[15], (L, GLA_HEADS, GLA_DV), 0.02),
        'w_out': nrm(ks[16], (L, D_MIX, D_MODEL), D_MIX ** -0.5),
        'g_norm_ffn2': 1.0 + nrm(ks[17], (L, D_MODEL), 0.02),
        'w_ffn2_in': nrm(ks[18], (L, D_MODEL, 2 * D_FF), D_MODEL ** -0.5),
        'w_ffn2_out': nrm(ks[19], (L, D_FF, D_MODEL), D_FF ** -0.5),
        'g_norm_final': 1.0 + nrm(ks[20], (D_MODEL,), 0.02),
        'w_ada_final': nrm(ks[21], (D_MODEL, 2 * D_MODEL), 0.5 * D_MODEL ** -0.5),
        'b_ada_final': nrm(ks[22], (2 * D_MODEL,), 0.02),
    }


def reference(x, c, w_ada, b_ada, g_norm_ffn1, w_ffn1_in, w_ffn1_out, g_norm_mix, w_in, w_dw, b_dw, g_conv_ln, b_conv_ln, w_gate_up, b_gate, g_gla_norm, w_out, g_norm_ffn2, w_ffn2_in, w_ffn2_out, g_norm_final, w_ada_final, b_ada_final):
    bsz = x.shape[0]
    c_act = jax.nn.silu(c)
    for l in range(DEPTH):
        mod = (c_act @ w_ada[l] + b_ada[l]).reshape(bsz, N_MOD, 1, D_MODEL)
        h = modulate(rmsnorm(x, g_norm_ffn1[l]), mod[:, 0], mod[:, 1])
        x = x + 0.5 * mod[:, 2] * swiglu(h, w_ffn1_in[l], w_ffn1_out[l])
        h = modulate(rmsnorm(x, g_norm_mix[l]), mod[:, 3], mod[:, 4])
        a, b, q, k, v, r, glr = jnp.split(h @ w_in[l], SPLITS, axis=-1)
        y_conv = conformer_conv(a, b, w_dw[l], b_dw[l], g_conv_ln[l], b_conv_ln[l])
        y_gla = gla(q, k, v, r, glr, w_gate_up[l], b_gate[l], g_gla_norm[l])
        x = x + mod[:, 5] * (jnp.concatenate([y_conv, y_gla], axis=-1) @ w_out[l])
        h = modulate(rmsnorm(x, g_norm_ffn2[l]), mod[:, 6], mod[:, 7])
        x = x + 0.5 * mod[:, 8] * swiglu(h, w_ffn2_in[l], w_ffn2_out[l])
    fmod = (c_act @ w_ada_final + b_ada_final).reshape(bsz, 2, 1, D_MODEL)
    return modulate(rmsnorm(x, g_norm_final), fmod[:, 0], fmod[:, 1])
```

```cpp
#include <hip/hip_runtime.h>
#include <cstdio>
#include <cstdint>

#ifndef N_LAUNCH_MODE
#define N_LAUNCH_MODE 0
#endif
#ifndef PROBE_KIND
#define PROBE_KIND 0
#endif

constexpr int BATCH = 2, SEQ = 8192, D = 1024, M = BATCH * SEQ, DFF = 2816, DCONV = 512, CWID = 31, NH = 4, DK = 64, DV = 128, DGLA = 512;
constexpr int NIN_SRC = 2576;
constexpr int NIN = 2816;
constexpr int NCHUNK = SEQ / 64;
constexpr int MODL = 9 * D, MODN = 2 * MODL + 2 * D;
constexpr float EPS = 1e-6f;
constexpr int CB_J0 = 0, CB_J1 = 2 * 2816, CB_J2 = CB_J1 + 2816, CBROWS = CB_J2 + 2 * 2816;
constexpr float LOG2E = 1.4426950408889634f;

#define LAS __attribute__((address_space(3)))
typedef unsigned short bf16;
typedef unsigned v4u __attribute__((ext_vector_type(4)));
typedef unsigned v2u __attribute__((ext_vector_type(2)));
typedef float f32x4 __attribute__((ext_vector_type(4)));
typedef float f32x2 __attribute__((ext_vector_type(2)));

__device__ __forceinline__ unsigned f2bf(float f) { unsigned u = __builtin_bit_cast(unsigned, f); return (u + 0x7fffu + ((u >> 16) & 1u)) >> 16; }
__device__ __forceinline__ unsigned pk2(float lo, float hi) { return f2bf(lo) | (f2bf(hi) << 16); }
__device__ __forceinline__ float bf2f(unsigned short h) { return __builtin_bit_cast(float, (unsigned)h << 16); }
__device__ __forceinline__ float bflo(unsigned w) { return __builtin_bit_cast(float, w << 16); }
__device__ __forceinline__ float bfhi(unsigned w) { return __builtin_bit_cast(float, w & 0xffff0000u); }
__device__ __forceinline__ float fsigmoid(float x) { return __builtin_amdgcn_rcpf(1.0f + __builtin_amdgcn_exp2f(-LOG2E * x)); }
#ifndef TILED
#define TILED 0
#endif
__host__ __device__ __forceinline__ size_t toff(int row, int col, int K) {
#if TILED
    return ((size_t)(row >> 7) * (size_t)(K >> 6) + (size_t)(col >> 6)) * 8192 + (size_t)(row & 127) * 64 + (size_t)(col & 63);
#else
    return (size_t)row * (size_t)K + (size_t)col;
#endif
}
__device__ __forceinline__ float wave_sum(float v) {
#pragma unroll
    for (int o = 1; o < 64; o <<= 1) v += __shfl_xor(v, o);
    return v;
}

namespace pg8 {
#define PG8_LAS __attribute__((address_space(3)))
typedef unsigned short bf16_t;
typedef short bf16x8 __attribute__((ext_vector_type(8)));
typedef unsigned u32x4 __attribute__((ext_vector_type(4)));
constexpr int BM = 256, BK = 64, HALF = 128, HTB = HALF * BK * 2, STAGE_BYTES = 8 * HTB, NXCD = 8, WGM = 8;

__host__ __device__ __forceinline__ int lds_byte(int r, int c) { const int st = (r >> 4) * 2 + (c >> 5), rr = r & 15, cc = c & 31, ob = rr * 64 + cc * 2; return st * 1024 + (ob ^ (((ob >> 9) & 1) << 5)); }
__host__ __device__ __forceinline__ void stage_rc(int b, int& R, int& C) { const int st = b / 1024, sb = b % 1024, swz = sb ^ (((sb >> 9) & 1) << 5); R = (st >> 1) * 16 + swz / 64; C = (st & 1) * 32 + (swz % 64) / 2; }
__host__ __device__ __forceinline__ int perm32(int rho) { const int n = rho >> 4, i = rho & 15; return 8 * (i >> 2) + 4 * n + (i & 3); }

struct Unit { int pm, pn; };
struct Gemm { const bf16_t* A; const bf16_t* Bt; int M, N, K; };

struct StaticOrder {
    int nM, nN, nwg, G, c;
    __host__ __device__ void init(int M_, int N_, int G_, int c_) { nM = M_ / BM; nN = N_ / BM; nwg = nM * nN; G = G_; c = c_; }
    __host__ __device__ bool next(int i, Unit& u) const {
        const long L = (long)i * G + c; if (L >= nwg) return false;
        int wgid = (int)L; { const int q = nwg / NXCD, r = nwg % NXCD, xcd = wgid % NXCD, off = wgid / NXCD; wgid = (xcd < r ? xcd * (q + 1) : r * (q + 1) + (xcd - r) * q) + off; }
        const int nig = WGM * nN, gid = wgid / nig, fm = gid * WGM, gsz = (nM - fm) < WGM ? (nM - fm) : WGM;
        u.pm = fm + ((wgid % nig) % gsz); u.pn = (wgid % nig) / gsz; return true;
    }
    __device__ __forceinline__ void a_ready(const Unit&) const {}
    __device__ __forceinline__ void done(const Unit&) const {}
};

__device__ __forceinline__ unsigned cvt_pk_bf16(float lo, float hi) { unsigned r; asm volatile("v_cvt_pk_bf16_f32 %0, %1, %2" : "=v"(r) : "v"(lo), "v"(hi)); return r; }


__device__ __forceinline__ void rows_rstd(const float* ssq, int row0, int fq, float (&rs)[2][4]) {
    f32x4 p[2][4];
#pragma unroll
    for (int ai = 0; ai < 2; ++ai)
#pragma unroll
        for (int m = 0; m < 4; ++m) p[ai][m] = *(const f32x4*)(ssq + (size_t)(row0 + ai * 128 + m * 16) * 16 + 4 * fq);
#pragma unroll
    for (int ai = 0; ai < 2; ++ai)
#pragma unroll
        for (int m = 0; m < 4; ++m) { float s = (p[ai][m].x + p[ai][m].y) + (p[ai][m].z + p[ai][m].w); s += __shfl_xor(s, 16); s += __shfl_xor(s, 32); rs[ai][m] = 1.0f / sqrtf(s * (1.0f / 1024.0f) + 1e-6f); }
}
struct EpiSwiGLU {
    static constexpr bool PERM = true, AFTER_DRAIN = false;
    bf16_t* O; const float* ssq; const float* cb; int ldc; int pad_;
    __device__ __forceinline__ void operator()(const f32x4 (&acc)[2][2][4][2], const Unit& u, int wr, int wc, int fr, int fq) const {
        const int row0 = u.pm * BM + wr * 64 + fr, cin = wc * 32 + 8 * fq, col0 = u.pn * HALF + cin;
        const float* cp = cb + (size_t)(u.pm >> 5) * CBROWS + u.pn * BM + cin;
        f32x4 bv[2][2];
#pragma unroll
        for (int bj = 0; bj < 2; ++bj)
#pragma unroll
            for (int n = 0; n < 2; ++n) bv[bj][n] = *(const f32x4*)(cp + bj * HALF + 4 * n);
        float rsv[2][4]; rows_rstd(ssq, row0, fq, rsv);
#pragma unroll
        for (int ai = 0; ai < 2; ++ai)
#pragma unroll
            for (int m = 0; m < 4; ++m) {
                const int row = row0 + ai * HALF + m * 16; const float rs = rsv[ai][m];
                bf16_t* rowp = O + toff(row, col0, ldc);
                float v[8];
#pragma unroll
                for (int n = 0; n < 2; ++n)
#pragma unroll
                    for (int e = 0; e < 4; ++e) { const float g = acc[ai][0][m][n][e] * rs + bv[0][n][e], up = acc[ai][1][m][n][e] * rs + bv[1][n][e]; v[4 * n + e] = g * fsigmoid(g) * up; }
                u32x4 w; w.x = cvt_pk_bf16(v[0], v[1]); w.y = cvt_pk_bf16(v[2], v[3]); w.z = cvt_pk_bf16(v[4], v[5]); w.w = cvt_pk_bf16(v[6], v[7]);
                *(u32x4*)rowp = w;
                asm volatile("" ::: "memory");
            }
    }
};

struct EpiResid {
    static constexpr bool PERM = true, AFTER_DRAIN = false;
    const float* base; float* out; const float* gate; bf16_t* Hn; const float* gs; float* ssq; int ldc; float coef;
    __device__ __forceinline__ void operator()(const f32x4 (&acc)[2][2][4][2], const Unit& u, int wr, int wc, int fr, int fq) const {
        const int row0 = u.pm * BM + wr * 64 + fr, col0 = u.pn * BM + wc * 32 + 8 * fq;
        const float* gp = gate + (size_t)(u.pm >> 5) * MODN + col0;
        const float* sp = gs + (size_t)(u.pm >> 5) * 1024 + col0;
        f32x4 gv[2][2], sv[2][2];
#pragma unroll
        for (int bj = 0; bj < 2; ++bj)
#pragma unroll
            for (int n = 0; n < 2; ++n) { gv[bj][n] = *(const f32x4*)(gp + bj * HALF + n * 4) * coef; sv[bj][n] = *(const f32x4*)(sp + bj * HALF + n * 4); }
#pragma unroll
        for (int ai = 0; ai < 2; ++ai)
#pragma unroll
            for (int mp = 0; mp < 2; ++mp) {
                f32x4 bs[2][2][2];
#pragma unroll
                for (int mm = 0; mm < 2; ++mm)
#pragma unroll
                    for (int bj = 0; bj < 2; ++bj)
#pragma unroll
                        for (int n = 0; n < 2; ++n) bs[mm][bj][n] = *(const f32x4*)(base + (size_t)(row0 + ai * HALF + (2 * mp + mm) * 16) * ldc + col0 + bj * HALF + n * 4);
#pragma unroll
                for (int mm = 0; mm < 2; ++mm) {
                    const int m = 2 * mp + mm, row = row0 + ai * HALF + m * 16;
                    const size_t off = (size_t)row * ldc + col0; float q = 0.f;
#pragma unroll
                    for (int bj = 0; bj < 2; ++bj) {
                        f32x4 xn[2];
#pragma unroll
                        for (int n = 0; n < 2; ++n) { xn[n] = bs[mm][bj][n] + gv[bj][n] * acc[ai][bj][m][n];
                            *(f32x4*)(out + off + bj * HALF + n * 4) = xn[n];
                            q += (xn[n].x * xn[n].x + xn[n].y * xn[n].y) + (xn[n].z * xn[n].z + xn[n].w * xn[n].w); }
                        const f32x4 h0 = xn[0] * sv[bj][0], h1 = xn[1] * sv[bj][1];
                        u32x4 w; w.x = cvt_pk_bf16(h0.x, h0.y); w.y = cvt_pk_bf16(h0.z, h0.w); w.z = cvt_pk_bf16(h1.x, h1.y); w.w = cvt_pk_bf16(h1.z, h1.w);
                        *(u32x4*)(Hn + toff(row, col0 + bj * HALF, ldc)) = w;
                    }
                    q += __shfl_xor(q, 16); q += __shfl_xor(q, 32);
                    if (fq == 0) ssq[(size_t)row * 16 + u.pn * 4 + wc] = q;
                }
                asm volatile("" ::: "memory");
            }
    }
};

struct EpiNull {
    static constexpr bool PERM = true, AFTER_DRAIN = false; int dummy;
    __device__ __forceinline__ void operator()(const f32x4 (&acc)[2][2][4][2], const Unit&, int, int, int, int) const {
#pragma unroll
        for (int ai = 0; ai < 2; ++ai)
#pragma unroll
            for (int bj = 0; bj < 2; ++bj)
#pragma unroll
                for (int m = 0; m < 4; ++m)
#pragma unroll
                    for (int n = 0; n < 2; ++n) asm volatile("" :: "v"(acc[ai][bj][m][n]));
    }
};

struct EpiMix {
    static constexpr bool PERM = true, AFTER_DRAIN = false;
    bf16_t* U; bf16_t* QKVR; float* LA; const float* bgate; const float* ssq; const float* cb;
    __device__ __forceinline__ void operator()(const f32x4 (&acc_)[2][2][4][2], const Unit& u, int wr, int wc, int fr, int fq) const {
        const int row0 = u.pm * BM + wr * 64 + fr, cin = wc * 32 + 8 * fq;
        f32x4 acc[2][2][4][2];
        {
            const float* cp = cb + (size_t)(u.pm >> 5) * CBROWS + u.pn * BM + cin;
            f32x4 cv[2][2];
#pragma unroll
            for (int bj = 0; bj < 2; ++bj)
#pragma unroll
                for (int n = 0; n < 2; ++n) cv[bj][n] = *(const f32x4*)(cp + bj * HALF + 4 * n);
            float rsv[2][4]; rows_rstd(ssq, row0, fq, rsv);
#pragma unroll
            for (int ai = 0; ai < 2; ++ai)
#pragma unroll
                for (int m = 0; m < 4; ++m) { const float rs = rsv[ai][m];
#pragma unroll
                    for (int bj = 0; bj < 2; ++bj)
#pragma unroll
                        for (int n = 0; n < 2; ++n) acc[ai][bj][m][n] = acc_[ai][bj][m][n] * rs + cv[bj][n]; }
        }
        if (u.pn < 4) {
#pragma unroll
            for (int ai = 0; ai < 2; ++ai)
#pragma unroll
                for (int m = 0; m < 4; ++m) {
                    bf16_t* rowp = U + (size_t)(row0 + ai * HALF + m * 16) * DCONV + u.pn * HALF + cin;
                    float v[8];
#pragma unroll
                    for (int n = 0; n < 2; ++n)
#pragma unroll
                        for (int e = 0; e < 4; ++e) v[4 * n + e] = acc[ai][0][m][n][e] * fsigmoid(acc[ai][1][m][n][e]);
                    u32x4 w; w.x = cvt_pk_bf16(v[0], v[1]); w.y = cvt_pk_bf16(v[2], v[3]); w.z = cvt_pk_bf16(v[4], v[5]); w.w = cvt_pk_bf16(v[6], v[7]);
                    *(u32x4*)rowp = w;
                    asm volatile("" ::: "memory");
                }
        } else if (u.pn < 10) {
            const float sc = (u.pn == 4) ? 0.125f : 1.0f;
#pragma unroll
            for (int ai = 0; ai < 2; ++ai)
#pragma unroll
                for (int m = 0; m < 4; ++m) {
                    bf16_t* rowp = QKVR + (size_t)(row0 + ai * HALF + m * 16) * 1536 + (u.pn - 4) * BM + cin;
#pragma unroll
                    for (int bj = 0; bj < 2; ++bj) {
                        const f32x4 v0 = acc[ai][bj][m][0] * sc, v1 = acc[ai][bj][m][1] * sc;
                        u32x4 w; w.x = cvt_pk_bf16(v0[0], v0[1]); w.y = cvt_pk_bf16(v0[2], v0[3]); w.z = cvt_pk_bf16(v1[0], v1[1]); w.w = cvt_pk_bf16(v1[2], v1[3]);
                        *(u32x4*)(rowp + bj * HALF) = w;
                    }
                    asm volatile("" ::: "memory");
                }
        } else {
            f32x4 bv[2][2];
#pragma unroll
            for (int bj = 0; bj < 2; ++bj)
#pragma unroll
                for (int n = 0; n < 2; ++n) bv[bj][n] = *(const f32x4*)(bgate + bj * HALF + cin + 4 * n);
#pragma unroll
            for (int ai = 0; ai < 2; ++ai)
#pragma unroll
                for (int m = 0; m < 4; ++m) {
                    float* rowp = LA + (size_t)(row0 + ai * HALF + m * 16) * 256 + cin;
#pragma unroll
                    for (int bj = 0; bj < 2; ++bj)
#pragma unroll
                        for (int n = 0; n < 2; ++n) {
                            const f32x4 z = acc[ai][bj][m][n] + bv[bj][n]; f32x4 o;
#pragma unroll
                            for (int e = 0; e < 4; ++e) { const float az = __builtin_fabsf(z[e]); o[e] = (fminf(z[e], 0.f) - __logf(1.0f + __expf(-az))) * (1.0f / 16.0f); }
                            *(f32x4*)(rowp + bj * HALF + 4 * n) = o;
                            asm volatile("" ::: "memory");
                        }
                }
        }
    }
};

template <class Epi, class Sched, bool ALIGN_EPI = false, bool SP2 = false>
__device__ __forceinline__ void gemm_phase(PG8_LAS unsigned char* lds, const Gemm g, const Sched& S, const Epi& E) {
    int tid_ = threadIdx.x; asm volatile("" : "+v"(tid_));
    const char* gA = (const char*)g.A; const char* gB = (const char*)g.Bt; asm volatile("" : "+s"(gA), "+s"(gB));
    const int tid = tid_, wid = __builtin_amdgcn_readfirstlane(tid >> 6), lane = tid & 63, wr = wid >> 2, wc = wid & 3, fr = lane & 15, fq = lane >> 4;
    const int K = g.K, nt = K / BK;
    unsigned voffA[2], voffB[2];
#pragma unroll
    for (int i = 0; i < 2; ++i) { int R, C; stage_rc(tid * 16 + i * 8192, R, C); const int Rb = Epi::PERM ? ((R & ~31) + perm32(R & 31)) : R;
        voffA[i] = (unsigned)(R * (TILED ? 64 : K) + C) * 2u; voffB[i] = (unsigned)(Rb * (TILED ? 64 : K) + C) * 2u; }
    const size_t kstep = TILED ? (size_t)(HALF * BK * 2) : (size_t)(BK * 2);
    const size_t hstep = (size_t)HALF * K * 2;
    const size_t tstep = 2 * hstep;
    const unsigned ldsw = (unsigned)wid * 1024u;
    const int aoff = lds_byte(wr * 64 + fr, fq * 8), boff = lds_byte(wc * 32 + fr, fq * 8);
#define PG8_SA(b, h) (((b) * 2 + (h)) * HTB)
#define PG8_SB(b, h) ((4 + (b) * 2 + (h)) * HTB)
#define PG8_STAGE(bufoff, gbase, voff) do { _Pragma("unroll") for (int _i = 0; _i < 2; ++_i) \
        __builtin_amdgcn_global_load_lds((const unsigned*)((const char*)(gbase) + (voff)[_i]), (PG8_LAS unsigned*)(lds + (bufoff) + ldsw + _i * 8192), 16, 0, 0); } while (0)
#define PG8_LDA(dst, b, h) do { _Pragma("unroll") for (int m = 0; m < 4; ++m) _Pragma("unroll") for (int k = 0; k < 2; ++k) dst[m][k] = *(const PG8_LAS bf16x8*)(lds + PG8_SA(b, h) + aoff + m * 2048 + k * 1024); } while (0)
#define PG8_LDB(dst, b, h) do { _Pragma("unroll") for (int n = 0; n < 2; ++n) _Pragma("unroll") for (int k = 0; k < 2; ++k) dst[n][k] = *(const PG8_LAS bf16x8*)(lds + PG8_SB(b, h) + boff + n * 2048 + k * 1024); } while (0)
#define PG8_MMA(ai, bj, At, Bt) do { __builtin_amdgcn_s_setprio(1); _Pragma("unroll") for (int m = 0; m < 4; ++m) _Pragma("unroll") for (int n = 0; n < 2; ++n) _Pragma("unroll") for (int k = 0; k < 2; ++k) \
        acc[ai][bj][m][n] = __builtin_amdgcn_mfma_f32_16x16x32_bf16(Bt[n][k], At[m][k], acc[ai][bj][m][n], 0, 0, 0); __builtin_amdgcn_s_setprio(0); } while (0)
#define PG8_WAIT_V(n) asm volatile("s_waitcnt vmcnt(" #n ")" ::: "memory")
#define PG8_WAIT_L(n) asm volatile("s_waitcnt lgkmcnt(" #n ")" ::: "memory")
#define PG8_BAR __builtin_amdgcn_s_barrier()
#define PG8_SCHED __builtin_amdgcn_sched_barrier(0)
    Unit cur, nxt; int ui = 0;
    if (!S.next(0, cur)) return;
    f32x4 acc[2][2][4][2];
#pragma unroll
    for (int a = 0; a < 2; ++a)
#pragma unroll
        for (int b = 0; b < 2; ++b)
#pragma unroll
            for (int m = 0; m < 4; ++m)
#pragma unroll
                for (int n = 0; n < 2; ++n) acc[a][b][m][n] = (f32x4){0.f, 0.f, 0.f, 0.f};
    bf16x8 At[4][2], B0[2][2], B1[2][2];
    const char* cA = gA + (size_t)cur.pm * tstep; const char* cB = gB + (size_t)cur.pn * tstep;
    S.a_ready(cur);
    if constexpr (SP2) {
        PG8_STAGE(PG8_SB(0, 0), cB, voffB); PG8_STAGE(PG8_SB(0, 1), cB + hstep, voffB); PG8_STAGE(PG8_SA(0, 0), cA, voffA); PG8_STAGE(PG8_SA(0, 1), cA + hstep, voffA);
        if (wr == 1) PG8_BAR;
        PG8_WAIT_V(2); PG8_BAR;
        PG8_STAGE(PG8_SB(1, 0), cB + kstep, voffB); PG8_STAGE(PG8_SA(1, 0), cA + kstep, voffA); PG8_STAGE(PG8_SB(1, 1), cB + hstep + kstep, voffB);
        PG8_WAIT_V(6); PG8_BAR;
    } else {
        PG8_STAGE(PG8_SB(0, 0), cB, voffB); PG8_STAGE(PG8_SA(0, 0), cA, voffA); PG8_STAGE(PG8_SB(0, 1), cB + hstep, voffB); PG8_STAGE(PG8_SA(0, 1), cA + hstep, voffA);
        if (wr == 1) PG8_BAR;
        PG8_WAIT_V(4); PG8_BAR;
        PG8_STAGE(PG8_SB(1, 0), cB + kstep, voffB); PG8_STAGE(PG8_SA(1, 0), cA + kstep, voffA); PG8_STAGE(PG8_SB(1, 1), cB + hstep + kstep, voffB);
        PG8_WAIT_V(6); PG8_BAR;
    }
    for (;;) {
        const bool has_next = S.next(ui + 1, nxt);
        const char* nA = has_next ? gA + (size_t)nxt.pm * tstep : cA; const char* nB = has_next ? gB + (size_t)nxt.pn * tstep : cB;
        for (int t = 0; t < nt; t += 2) {
            const bool last = (t == nt - 2);
            const char* a1 = cA + (size_t)(t + 1) * kstep;
            const char* a2 = last ? nA : cA + (size_t)(t + 2) * kstep; const char* b2 = last ? nB : cB + (size_t)(t + 2) * kstep;
            const char* a3 = a2 + kstep; const char* b3 = b2 + kstep;
            if (last && has_next) S.a_ready(nxt);
            if constexpr (SP2) {
            PG8_LDB(B0, 0, 0); PG8_LDB(B1, 0, 1); PG8_SCHED; PG8_LDA(At, 0, 0); PG8_STAGE(PG8_SA(1, 1), a1 + hstep, voffA);
            PG8_WAIT_V(8); PG8_WAIT_L(0); PG8_BAR; PG8_MMA(0, 0, At, B0); PG8_MMA(0, 1, At, B1); PG8_BAR; PG8_SCHED;
            PG8_LDA(At, 0, 1); PG8_STAGE(PG8_SB(0, 0), b2, voffB); PG8_STAGE(PG8_SB(0, 1), b2 + hstep, voffB); PG8_STAGE(PG8_SA(0, 0), a2, voffA);
            PG8_WAIT_V(8); PG8_WAIT_L(0); PG8_BAR; PG8_MMA(1, 0, At, B0); PG8_MMA(1, 1, At, B1); PG8_BAR; PG8_SCHED;
            PG8_LDB(B0, 1, 0); PG8_LDB(B1, 1, 1); PG8_SCHED; PG8_LDA(At, 1, 0); PG8_STAGE(PG8_SA(0, 1), a2 + hstep, voffA);
            PG8_WAIT_V(8); PG8_WAIT_L(0); PG8_BAR; PG8_MMA(0, 0, At, B0); PG8_MMA(0, 1, At, B1); PG8_BAR; PG8_SCHED;
            PG8_LDA(At, 1, 1); PG8_STAGE(PG8_SB(1, 0), b3, voffB); PG8_STAGE(PG8_SB(1, 1), b3 + hstep, voffB); PG8_STAGE(PG8_SA(1, 0), a3, voffA);
            PG8_WAIT_V(8); PG8_WAIT_L(0); PG8_BAR; PG8_MMA(1, 0, At, B0); PG8_MMA(1, 1, At, B1); PG8_BAR; PG8_SCHED;
            } else {
            PG8_LDB(B0, 0, 0); PG8_SCHED; PG8_LDA(At, 0, 0); PG8_STAGE(PG8_SA(1, 1), a1 + hstep, voffA);
            PG8_WAIT_L(8); PG8_BAR; PG8_WAIT_L(0); PG8_MMA(0, 0, At, B0); PG8_BAR; PG8_SCHED;
            PG8_LDB(B1, 0, 1); PG8_STAGE(PG8_SB(0, 0), b2, voffB);
            PG8_BAR; PG8_WAIT_L(0); PG8_MMA(0, 1, At, B1); PG8_BAR;
            PG8_LDA(At, 0, 1); PG8_STAGE(PG8_SA(0, 0), a2, voffA);
            PG8_BAR; PG8_WAIT_L(0); PG8_MMA(1, 0, At, B0); PG8_BAR; PG8_SCHED;
            PG8_STAGE(PG8_SB(0, 1), b2 + hstep, voffB);
            PG8_WAIT_V(6); PG8_BAR; PG8_MMA(1, 1, At, B1); PG8_BAR;
            PG8_LDB(B0, 1, 0); PG8_SCHED; PG8_LDA(At, 1, 0); PG8_STAGE(PG8_SA(0, 1), a2 + hstep, voffA);
            PG8_WAIT_L(8); PG8_BAR; PG8_WAIT_L(0); PG8_MMA(0, 0, At, B0); PG8_BAR; PG8_SCHED;
            PG8_LDB(B1, 1, 1); PG8_STAGE(PG8_SB(1, 0), b3, voffB);
            PG8_BAR; PG8_WAIT_L(0); PG8_MMA(0, 1, At, B1); PG8_BAR;
            PG8_LDA(At, 1, 1); PG8_STAGE(PG8_SA(1, 0), a3, voffA);
            PG8_BAR; PG8_WAIT_L(0); PG8_MMA(1, 0, At, B0); PG8_BAR; PG8_SCHED;
            PG8_STAGE(PG8_SB(1, 1), b3 + hstep, voffB);
            PG8_WAIT_V(6); PG8_BAR; PG8_MMA(1, 1, At, B1); PG8_BAR;
            }
        }
        if constexpr (ALIGN_EPI) { if (wr == 0) PG8_BAR; }
        if constexpr (!Epi::AFTER_DRAIN) { E(acc, cur, wr, wc, fr, fq); S.done(cur); }
        if (!has_next) break;
#pragma unroll
        for (int a = 0; a < 2; ++a)
#pragma unroll
            for (int b = 0; b < 2; ++b)
#pragma unroll
                for (int m = 0; m < 4; ++m)
#pragma unroll
                    for (int n = 0; n < 2; ++n) acc[a][b][m][n] = (f32x4){0.f, 0.f, 0.f, 0.f};
        cur = nxt; cA = nA; cB = nB; ++ui;
        if constexpr (ALIGN_EPI) { if (wr == 1) PG8_BAR; }
    }
    PG8_WAIT_V(0);
    if constexpr (!ALIGN_EPI) { if (wr == 0) PG8_BAR; }
    PG8_BAR;
#undef PG8_SA
#undef PG8_SB
#undef PG8_STAGE
#undef PG8_LDA
#undef PG8_LDB
#undef PG8_MMA
#undef PG8_WAIT_V
#undef PG8_WAIT_L
#undef PG8_BAR
#undef PG8_SCHED
}
}

constexpr size_t MiB = 1u << 20;
constexpr size_t WS_CTL = 0, CTL_ZERO_BYTES = 1 * MiB;
constexpr size_t WS_MOD = 1 * MiB;
constexpr size_t WS_PART = 1 * MiB + 256 * 1024;
constexpr size_t WS_W = 3 * MiB;
constexpr size_t WL_FF1IN = 0, WL_FF1OUT = WL_FF1IN + (size_t)2 * DFF * D, WL_WIN = WL_FF1OUT + (size_t)D * DFF, WL_WOUT = WL_WIN + (size_t)NIN * D,
                 WL_FF2IN = WL_WOUT + (size_t)D * D, WL_FF2OUT = WL_FF2IN + (size_t)2 * DFF * D, WL_ELEMS = WL_FF2OUT + (size_t)D * DFF;
constexpr size_t WS_ACT = 84 * MiB;
constexpr size_t WS_U = WS_ACT, WS_QKVR = WS_ACT + 16 * MiB, WS_LA = WS_ACT + 64 * MiB;
constexpr size_t WS_H = 172 * MiB;
constexpr size_t WS_UC = WS_H;
constexpr size_t WS_Y = 204 * MiB;
constexpr size_t WS_SP = 236 * MiB;
constexpr size_t WS_GC = 268 * MiB;
constexpr size_t WS_SSQ = 268 * MiB + 512 * 1024;
constexpr size_t WS_GS = 2 * MiB + 512 * 1024;
constexpr size_t WS_CB = WS_GS + 64 * 1024;
constexpr size_t WS_END = 270 * MiB;
static_assert(WS_W + 2 * WL_ELEMS * 2 <= WS_ACT, "weights fit");
static_assert(WS_ACT + (size_t)M * DFF * 2 <= WS_H, "act fits");
constexpr int CW_BAR = 4096;

constexpr int RING_BYTES = 131072, MISC_OFF = RING_BYTES + 320, LDS_BYTES = 147456;

#define XB_TMO      128
#define XB_XCNT(j)  (256  + 64 * (j))
#define XB_XSUB(j)  (1280 + 64 * (j))
#define XB_XGEN(j)  (2304 + 64 * (j))
#define XB_TOP      3328
#define XB_TOPGEN   3392
#define XCD_BAR_WORDS 3456
#define XB_SPIN_CAP (1u << 18)
__device__ __forceinline__ unsigned xb_ld(unsigned* p)              { return __hip_atomic_load(p, __ATOMIC_RELAXED, __HIP_MEMORY_SCOPE_AGENT); }
__device__ __forceinline__ unsigned xb_add(unsigned* p, unsigned v) { return __hip_atomic_fetch_add(p, v, __ATOMIC_RELAXED, __HIP_MEMORY_SCOPE_AGENT); }
__device__ __forceinline__ unsigned xb_xcc_id() { return (unsigned)__builtin_amdgcn_s_getreg((3 << 11) | 20) & 0xFu; }
#define XB_SPIN(cond, bar) do { unsigned _sp = 0; while (cond) { __builtin_amdgcn_s_sleep(1); \
    if ((++_sp & 255u) == 0u) { if (xb_ld(&(bar)[XB_TMO])) break; if (_sp > XB_SPIN_CAP) { atomicAdd(&(bar)[XB_TMO], 1u); break; } } } } while (0)
struct XcdBarrier { unsigned* bar; unsigned x; volatile LAS unsigned* st; };
__device__ __forceinline__ XcdBarrier xcd_barrier_post(unsigned* bar, volatile LAS unsigned* st) {
    XcdBarrier b; b.bar = bar; b.x = xb_xcc_id(); b.st = st;
    if (threadIdx.x == 0) (void)xb_add(&bar[XB_XCNT(b.x)], 1u);
    return b;
}
__device__ __forceinline__ void xcd_barrier_complete(unsigned* bar, unsigned x, unsigned& nloc, unsigned& nx) {
    const unsigned G = gridDim.x * gridDim.y * gridDim.z;
    unsigned sum, cnt, mine, sp = 0u;
    for (;;) {
        sum = 0u; cnt = 0u; mine = 0u;
#pragma unroll
        for (unsigned j = 0; j < 16; ++j) { const unsigned c = xb_ld(&bar[XB_XCNT(j)]); sum += c; cnt += (c > 0u) ? 1u : 0u; mine = (j == x) ? c : mine; }
        if (sum == G) break;
        __builtin_amdgcn_s_sleep(1);
        if ((++sp & 255u) == 0u) { if (xb_ld(&bar[XB_TMO])) break; if (sp > XB_SPIN_CAP) { atomicAdd(&bar[XB_TMO], 1u); break; } }
    }
    nloc = mine > 0u ? mine : 1u; nx = cnt > 0u ? cnt : 1u;
}
__device__ __forceinline__ void xcd_barrier(const XcdBarrier& b) {
    asm volatile("s_waitcnt vmcnt(0)" ::: "memory");
    __syncthreads();
    if (threadIdx.x == 0) {
        unsigned* bar = b.bar;
        __builtin_amdgcn_s_waitcnt(0);
        unsigned nloc = b.st[0], nx = b.st[1];
        if (nloc == 0u) { xcd_barrier_complete(bar, b.x, nloc, nx); b.st[0] = nloc; b.st[1] = nx; }
        const unsigned old = xb_add(&bar[XB_XSUB(b.x)], 1u);
        const unsigned gen = old / nloc;
        if (old + 1u == (gen + 1u) * nloc) {
            __builtin_amdgcn_fence(__ATOMIC_RELEASE, "agent");
            asm volatile("s_waitcnt vmcnt(0)" ::: "memory");
            const unsigned og = xb_add(&bar[XB_TOP], 1u);
            const unsigned tg = og / nx;
            if (og + 1u == (tg + 1u) * nx) xb_add(&bar[XB_TOPGEN], 1u);
            else XB_SPIN(xb_ld(&bar[XB_TOPGEN]) == tg, bar);
            __builtin_amdgcn_fence(__ATOMIC_ACQUIRE, "agent");
            xb_add(&bar[XB_XGEN(b.x)], 1u);
            asm volatile("s_waitcnt vmcnt(0)" ::: "memory");
        } else {
            XB_SPIN(xb_ld(&bar[XB_XGEN(b.x)]) == gen, bar);
            __builtin_amdgcn_fence(__ATOMIC_ACQUIRE, "agent");
            asm volatile("s_waitcnt vmcnt(0)" ::: "memory");
        }
    }
    __syncthreads();
}

struct Args { const float* in[23]; float* out; unsigned char* ws; int ph_lo, ph_hi; };
enum { I_X = 0, I_C, I_WADA, I_BADA, I_G1, I_W1IN, I_W1OUT, I_GMIX, I_WIN, I_WDW, I_BDW, I_GCLN, I_BCLN, I_WGU, I_BGATE, I_GGLA, I_WOUT, I_G2, I_W2IN, I_W2OUT, I_GFIN, I_WADAF, I_BADAF };

__device__ __forceinline__ void tr_store(bf16* WT, int K, int drow0, int k0, LAS float* scr, int lane) {
    asm volatile("s_waitcnt lgkmcnt(0)" ::: "memory");
    const int c = lane & 7;
#pragma unroll
    for (int j = 0; j < 4; ++j) { const int n = (lane >> 3) + 8 * j; const LAS float* s = scr + (8 * c) * 33 + n;
        v4u o; o.x = pk2(s[0 * 33], s[1 * 33]); o.y = pk2(s[2 * 33], s[3 * 33]); o.z = pk2(s[4 * 33], s[5 * 33]); o.w = pk2(s[6 * 33], s[7 * 33]);
        *(v4u*)(WT + toff(drow0 + n, k0 + 8 * c, K)) = o; }
    asm volatile("s_waitcnt lgkmcnt(0)" ::: "memory");
}
__device__ __forceinline__ void tr_item(const float* W, int K, int N, int n0, int k0, bf16* WT, int drow0, LAS float* scr, int lane) {
#pragma unroll 8
    for (int i = 0; i < 32; ++i) { const int kk = 2 * i + (lane >> 5); scr[kk * 33 + (lane & 31)] = W[(size_t)(k0 + kk) * N + n0 + (lane & 31)]; }
    tr_store(WT, K, drow0, k0, scr, lane);
}
__device__ __forceinline__ int pair_row(int n0, int half) { return 256 * (n0 >> 7) + 128 * half + (n0 & 127); }

__device__ __forceinline__ void p0_prologue(const Args& A, LAS unsigned char* lds, int vcu, int G, int tid, int wave, int lane) {
    LAS float* scr = (LAS float*)(lds + wave * 8704);
    LAS float* ca = (LAS float*)(lds + 8 * 8704);
    for (int i = tid; i < 2 * D; i += 512) { const float c = A.in[I_C][i]; ca[i] = c * fsigmoid(c); }
    __syncthreads();
    bf16* WB = (bf16*)(A.ws + WS_W);
    float* PART = (float*)(A.ws + WS_PART);
    const int gw = vcu * 8 + wave, NGW = G * 8;
    constexpr int NGEMV = 320 * 8;
    constexpr int S0 = 16 * 176, S1 = 44 * 32, S2 = 16 * 80, S3 = 16 * 8, S4 = 16 * 32, PER_LAYER = 2 * S0 + 2 * S1 + S2 + S3 + S4;
    constexpr int NITEMS = NGEMV + 2 * PER_LAYER;
    for (int it = gw; it < NITEMS; it += NGW) {
        if (it < NGEMV) {
            const int s = it >> 3, kc = it & 7, k0 = kc * 128;
            const float* W; int N, col0, gcol0;
            if (s < 144) { W = A.in[I_WADA]; N = MODL; col0 = s * 64; gcol0 = col0; }
            else if (s < 288) { W = A.in[I_WADA] + (size_t)D * MODL; N = MODL; col0 = (s - 144) * 64; gcol0 = MODL + col0; }
            else { W = A.in[I_WADAF]; N = 2 * D; col0 = (s - 288) * 64; gcol0 = 2 * MODL + col0; }
            const float* w = W + (size_t)k0 * N + col0 + lane;
            float a0 = 0.f, a1 = 0.f;
#pragma unroll 16
            for (int kk = 0; kk < 128; ++kk) { const float wv = w[(size_t)kk * N]; a0 += ca[k0 + kk] * wv; a1 += ca[D + k0 + kk] * wv; }
            PART[((size_t)0 * MODN + gcol0 + lane) * 8 + kc] = a0; PART[((size_t)1 * MODN + gcol0 + lane) * 8 + kc] = a1;
            continue;
        }
        int r = it - NGEMV; const int l = r / PER_LAYER; r -= l * PER_LAYER;
        bf16* WL = WB + (size_t)l * WL_ELEMS;
        if (r < S0) { const int kb = r / 176, nb = r % 176, n0 = nb * 32; const int dr = n0 < DFF ? pair_row(n0, 0) : pair_row(n0 - DFF, 1);
            tr_item(A.in[I_W1IN] + (size_t)l * D * 2 * DFF, D, 2 * DFF, n0, kb * 64, WL + WL_FF1IN, dr, scr, lane); continue; } r -= S0;
        if (r < S1) { const int kb = r / 32, nb = r % 32; tr_item(A.in[I_W1OUT] + (size_t)l * DFF * D, DFF, D, nb * 32, kb * 64, WL + WL_FF1OUT, nb * 32, scr, lane); continue; } r -= S1;
        if (r < S2) { const int kb = r / 80, nb = r % 80, n0 = nb * 32; const int dr = n0 < 512 ? pair_row(n0, 0) : (n0 < 1024 ? pair_row(n0 - 512, 1) : n0);
            tr_item(A.in[I_WIN] + (size_t)l * D * NIN_SRC, D, NIN_SRC, n0, kb * 64, WL + WL_WIN, dr, scr, lane); continue; } r -= S2;
        if (r < S3) {
            const int kb = r / 8, jb = r % 8, k0 = kb * 64, j0 = jb * 32;
            const float* wgu = A.in[I_WGU] + (size_t)l * 16 * 256 + j0 + (lane & 31);
            float wg[16];
#pragma unroll
            for (int q = 0; q < 16; ++q) wg[q] = wgu[q * 256];
            const float* Win = A.in[I_WIN] + (size_t)l * D * NIN_SRC + 2560;
#pragma unroll 4
            for (int i = 0; i < 32; ++i) { const int kk = 2 * i + (lane >> 5); const f32x4* wr = (const f32x4*)(Win + (size_t)(k0 + kk) * NIN_SRC);
                float s = 0.f;
#pragma unroll
                for (int q = 0; q < 4; ++q) { const f32x4 x = wr[q]; s += x[0] * wg[4 * q] + x[1] * wg[4 * q + 1] + x[2] * wg[4 * q + 2] + x[3] * wg[4 * q + 3]; }
                scr[kk * 33 + (lane & 31)] = s; }
            tr_store(WL + WL_WIN, D, 2560 + j0, k0, scr, lane); continue; } r -= S3;
        if (r < S4) { const int kb = r / 32, nb = r % 32; tr_item(A.in[I_WOUT] + (size_t)l * D * D, D, D, nb * 32, kb * 64, WL + WL_WOUT, nb * 32, scr, lane); continue; } r -= S4;
        if (r < S0) { const int kb = r / 176, nb = r % 176, n0 = nb * 32; const int dr = n0 < DFF ? pair_row(n0, 0) : pair_row(n0 - DFF, 1);
            tr_item(A.in[I_W2IN] + (size_t)l * D * 2 * DFF, D, 2 * DFF, n0, kb * 64, WL + WL_FF2IN, dr, scr, lane); continue; } r -= S0;
        { const int kb = r / 32, nb = r % 32; tr_item(A.in[I_W2OUT] + (size_t)l * DFF * D, DFF, D, nb * 32, kb * 64, WL + WL_FF2OUT, nb * 32, scr, lane); }
    }
}
__device__ __forceinline__ float mod_sum(const float* PART, const Args& A, int b, int gc) {
    const f32x4* p = (const f32x4*)(PART + ((size_t)b * MODN + gc) * 8); const f32x4 u = p[0], v = p[1];
    return (((u.x + u.y) + (u.z + u.w)) + ((v.x + v.y) + (v.z + v.w))) + (gc < 2 * MODL ? A.in[I_BADA][gc] : A.in[I_BADAF][gc - 2 * MODL]);
}
__device__ __forceinline__ void p0b_phase(const Args& A, LAS unsigned char* lds, int G, int tid, int wave, int lane, int gw, int NGW) {
    const float* PART = (const float*)(A.ws + WS_PART); float* MOD = (float*)(A.ws + WS_MOD);
    float* GS = (float*)(A.ws + WS_GS); float* CB = (float*)(A.ws + WS_CB); float* SSQ = (float*)(A.ws + WS_SSQ);
    LAS float* shL = (LAS float*)lds;
    LAS float* gsL = shL + 12 * 1024;
    for (int e = blockIdx.x * 512 + tid; e < 2 * MODN; e += G * 512) { const int b = e / MODN, gc = e - b * MODN; MOD[e] = mod_sum(PART, A, b, gc); }
#pragma unroll 8
    for (int e = tid; e < 12 * 1024; e += 512) { const int k = e & 1023, b = (e >> 10) & 1, j = (e >> 11) % 3, l = e / 6144;
        shL[e] = mod_sum(PART, A, b, l * MODL + (3 * j) * D + k); }
    for (int e = tid; e < 2048; e += 512) { const int k = e & 1023, b = e >> 10; gsL[e] = A.in[I_G1][k] * (1.0f + mod_sum(PART, A, b, D + k)); }
    for (int e = blockIdx.x * 512 + tid; e < 12 * 1024; e += G * 512) { const int k = e & 1023, b = (e >> 10) & 1, j = (e >> 11) % 3, l = e / 6144;
        const float* g = (j == 0 ? A.in[I_G1] : j == 1 ? A.in[I_GMIX] : A.in[I_G2]) + l * D;
        GS[e] = g[k] * (1.0f + mod_sum(PART, A, b, l * MODL + (3 * j + 1) * D + k)); }
    __syncthreads();
    const bf16* WB = (const bf16*)(A.ws + WS_W);
    for (int r0 = gw; r0 < 2 * CBROWS; r0 += 4 * NGW) {
        v4u w0[4], w1[4]; int ll[4], rrv[4], jj[4];
#pragma unroll
        for (int q = 0; q < 4; ++q) { const int r = r0 + q * NGW; const bool ok = r < 2 * CBROWS; const int rc = ok ? r : gw;
            const int l = rc / CBROWS, rr = rc - l * CBROWS; const int j = rr < CB_J1 ? 0 : (rr < CB_J2 ? 1 : 2);
            const bf16* wrow = WB + (size_t)l * WL_ELEMS + (j == 0 ? WL_FF1IN + toff(rr, lane * 16, D) : j == 1 ? WL_WIN + toff(rr - CB_J1, lane * 16, D) : WL_FF2IN + toff(rr - CB_J2, lane * 16, D));
            w0[q] = *(const v4u*)(wrow); w1[q] = *(const v4u*)(wrow + 8); ll[q] = l; rrv[q] = ok ? rr : -1; jj[q] = j; }
#pragma unroll
        for (int q = 0; q < 4; ++q) {
            const float wf[16] = {bflo(w0[q].x), bfhi(w0[q].x), bflo(w0[q].y), bfhi(w0[q].y), bflo(w0[q].z), bfhi(w0[q].z), bflo(w0[q].w), bfhi(w0[q].w), bflo(w1[q].x), bfhi(w1[q].x), bflo(w1[q].y), bfhi(w1[q].y), bflo(w1[q].z), bfhi(w1[q].z), bflo(w1[q].w), bfhi(w1[q].w)};
            const LAS float* s0 = shL + ((ll[q] * 3 + jj[q]) * 2 + 0) * 1024 + lane * 16; const LAS float* s1 = s0 + 1024;
            float a0 = 0.f, a1 = 0.f;
#pragma unroll
            for (int e = 0; e < 16; ++e) { a0 += wf[e] * s0[e]; a1 += wf[e] * s1[e]; }
            a0 = wave_sum(a0); a1 = wave_sum(a1);
            if (lane == 0 && rrv[q] >= 0) { CB[(size_t)(ll[q] * 2 + 0) * CBROWS + rrv[q]] = a0; CB[(size_t)(ll[q] * 2 + 1) * CBROWS + rrv[q]] = a1; }
        }
    }
    bf16* H = (bf16*)(A.ws + WS_H);
    for (int m = gw; m < M; m += NGW) {
        const f32x4* xr = (const f32x4*)(A.in[I_X] + (size_t)m * D) + lane; const LAS f32x4* gl = (const LAS f32x4*)(gsL + (m >> 13) * 1024) + lane;
        float q = 0.f;
#pragma unroll
        for (int j = 0; j < 4; ++j) { const f32x4 v = xr[64 * j]; q += (v.x * v.x + v.y * v.y) + (v.z * v.z + v.w * v.w); const f32x4 y = v * gl[64 * j];
            *(unsigned long long*)(H + toff(m, 4 * lane + 256 * j, D)) = (unsigned long long)pk2(y.x, y.y) | ((unsigned long long)pk2(y.z, y.w) << 32); }
        q = wave_sum(q);
        if (lane < 16) SSQ[(size_t)m * 16 + lane] = lane == 0 ? q : 0.f;
    }
}

__device__ __forceinline__ void normmod_row(const float* xrow, const float* g, const float* shift, const float* scale, bf16* orow, int lane) {
    const f32x4* xr = (const f32x4*)xrow + lane;
    f32x4 v[4]; float s = 0.f;
#pragma unroll
    for (int j = 0; j < 4; ++j) { v[j] = xr[64 * j]; s += (v[j].x * v[j].x + v[j].y * v[j].y) + (v[j].z * v[j].z + v[j].w * v[j].w); }
    const float rstd = 1.0f / sqrtf(wave_sum(s) * (1.0f / D) + EPS);
    unsigned long long* o8 = (unsigned long long*)orow + lane;
#pragma unroll
    for (int j = 0; j < 4; ++j) { const f32x4 gg = ((const f32x4*)g)[lane + 64 * j], sh = ((const f32x4*)shift)[lane + 64 * j], sc = ((const f32x4*)scale)[lane + 64 * j];
        const f32x4 y = (v[j] * rstd * gg) * (sc + 1.0f) + sh;
        o8[64 * j] = (unsigned long long)pk2(y.x, y.y) | ((unsigned long long)pk2(y.z, y.w) << 32); }
}
__device__ __forceinline__ void norm_phase(const float* X, const float* g, const float* MOD, int shift_off, int scale_off, bf16* H, int gw, int NGW, int lane) {
    for (int m = gw; m < M; m += NGW) { const float* mb = MOD + (size_t)(m >> 13) * MODN; normmod_row(X + (size_t)m * D, g, mb + shift_off, mb + scale_off, H + (size_t)m * D, lane); }
}
__device__ __forceinline__ void final_phase(float* X, const float* g, const float* MOD, int gw, int NGW, int lane) {
    for (int m = gw; m < M; m += NGW) { const float* mb = MOD + (size_t)(m >> 13) * MODN + 2 * MODL;
        f32x4* xr = (f32x4*)(X + (size_t)m * D) + lane; f32x4 v[4]; float s = 0.f;
#pragma unroll
        for (int j = 0; j < 4; ++j) { v[j] = xr[64 * j]; s += (v[j].x * v[j].x + v[j].y * v[j].y) + (v[j].z * v[j].z + v[j].w * v[j].w); }
        const float rstd = 1.0f / sqrtf(wave_sum(s) * (1.0f / D) + EPS);
#pragma unroll
        for (int j = 0; j < 4; ++j) { const f32x4 gg = ((const f32x4*)g)[lane + 64 * j], sh = ((const f32x4*)mb)[lane + 64 * j], sc = ((const f32x4*)(mb + D))[lane + 64 * j];
            xr[64 * j] = (v[j] * rstd * gg) * (sc + 1.0f) + sh; } }
}

__device__ __forceinline__ void conv_unit(const Args& A, int l, int unit, LAS unsigned char* lds, int tid, int wave, int lane) {
    const int b = unit >> 8, t0 = (unit & 255) * 32;
    LAS unsigned short* uL = (LAS unsigned short*)lds;
    LAS float* yL = (LAS float*)(lds + 63488);
    const bf16* U = (const bf16*)(A.ws + WS_U); bf16* Y = (bf16*)(A.ws + WS_Y);
    for (int r = wave; r < 62; r += 8) { const int t = t0 - 30 + r; v4u v = (v4u){0u, 0u, 0u, 0u};
        if (t >= 0) v = *(const v4u*)(U + ((size_t)(b * SEQ + t)) * DCONV + lane * 8);
        *(LAS v4u*)(uL + r * 512 + lane * 8) = v; }
    __syncthreads();
    {
        const int ch = tid; float w[31];
#pragma unroll
        for (int i = 0; i < 31; ++i) w[i] = A.in[I_WDW][(size_t)(l * CWID + i) * DCONV + ch];
        const float bias = A.in[I_BDW][l * DCONV + ch];
        float acc[32];
#pragma unroll
        for (int r = 0; r < 32; ++r) acc[r] = bias;
#pragma unroll
        for (int i = 0; i < 62; ++i) { const float v = bf2f(uL[i * 512 + ch]);
#pragma unroll
            for (int r = 0; r < 32; ++r) { const int wi = i - r; if (wi >= 0 && wi <= 30) acc[r] += v * w[wi]; } }
#pragma unroll
        for (int r = 0; r < 32; ++r) yL[r * 512 + ch] = acc[r];
    }
    __syncthreads();
    for (int r = wave; r < 32; r += 8) {
        const f32x4 a0 = *(const LAS f32x4*)(yL + r * 512 + lane * 8), a1 = *(const LAS f32x4*)(yL + r * 512 + lane * 8 + 4);
        float v[8] = {a0.x, a0.y, a0.z, a0.w, a1.x, a1.y, a1.z, a1.w}; float s = 0.f;
#pragma unroll
        for (int e = 0; e < 8; ++e) s += v[e];
        const float mean = wave_sum(s) * (1.0f / DCONV); float q = 0.f;
#pragma unroll
        for (int e = 0; e < 8; ++e) { v[e] -= mean; q += v[e] * v[e]; }
        const float rstd = 1.0f / sqrtf(wave_sum(q) * (1.0f / DCONV) + EPS);
        const float* gl = A.in[I_GCLN] + l * DCONV + lane * 8; const float* bl = A.in[I_BCLN] + l * DCONV + lane * 8;
        float o[8];
#pragma unroll
        for (int e = 0; e < 8; ++e) { const float z = v[e] * rstd * gl[e] + bl[e]; o[e] = z * fsigmoid(z); }
        v4u w; w.x = pk2(o[0], o[1]); w.y = pk2(o[2], o[3]); w.z = pk2(o[4], o[5]); w.w = pk2(o[6], o[7]);
        *(v4u*)(Y + toff(b * SEQ + t0 + r, lane * 8, D)) = w;
    }
    __syncthreads();
}

__device__ __forceinline__ void ld_tile_bf16(const bf16* src, int pitch, int ncol, LAS float* dst, int tid) {
    const int per = ncol / 8;
    for (int p = tid; p < 64 * per; p += 512) { const int j = p / per, c = (p % per) * 8; const v4u w = *(const v4u*)(src + (size_t)j * pitch + c);
        LAS float* d = dst + j * ncol + c;
        d[0] = bflo(w.x); d[1] = bfhi(w.x); d[2] = bflo(w.y); d[3] = bfhi(w.y); d[4] = bflo(w.z); d[5] = bfhi(w.z); d[6] = bflo(w.w); d[7] = bfhi(w.w); }
}
__device__ __forceinline__ void gla1_unit(const Args& A, int unit, LAS unsigned char* lds, int tid) {
    const int bh = unit >> 7, n = unit & 127, b = bh >> 2, h = bh & 3; const size_t row0 = (size_t)b * SEQ + (size_t)n * 64;
    LAS float* bcL = (LAS float*)lds; LAS float* kL = bcL + 4096; LAS float* vL = kL + 4096;
    const bf16* QKVR = (const bf16*)(A.ws + WS_QKVR); const float* LAp = (const float*)(A.ws + WS_LA);
    float* UC = (float*)(A.ws + WS_UC); float* GC = (float*)(A.ws + WS_GC);
    for (int p = tid; p < 1024; p += 512) { const int j = p >> 4, c = (p & 15) * 4; *(LAS f32x4*)(bcL + j * 64 + c) = *(const f32x4*)(LAp + (row0 + j) * 256 + h * 64 + c); }
    ld_tile_bf16(QKVR + row0 * 1536 + 256 + h * 64, 1536, 64, kL, tid);
    ld_tile_bf16(QKVR + row0 * 1536 + 512 + h * 128, 1536, 128, vL, tid);
    __syncthreads();
    if (tid < 64) { float s = 0.f;
        for (int j = 0; j < 64; ++j) { s += bcL[j * 64 + tid]; bcL[j * 64 + tid] = s; }
        GC[(size_t)unit * 64 + tid] = __expf(s); }
    __syncthreads();
    for (int e = tid; e < 4096; e += 512) { const int col = e & 63; kL[e] *= __expf(bcL[63 * 64 + col] - bcL[e]); }
    __syncthreads();
    const int kk = tid >> 3, vv0 = (tid & 7) * 16; float a[16];
#pragma unroll
    for (int i = 0; i < 16; ++i) a[i] = 0.f;
    for (int j = 0; j < 64; ++j) { const float kv = kL[j * 64 + kk];
#pragma unroll
        for (int q = 0; q < 4; ++q) { const f32x4 x = *(const LAS f32x4*)(vL + j * 128 + vv0 + 4 * q); a[4 * q] += kv * x.x; a[4 * q + 1] += kv * x.y; a[4 * q + 2] += kv * x.z; a[4 * q + 3] += kv * x.w; } }
    float* up = UC + (size_t)unit * 8192 + kk * 128 + vv0;
#pragma unroll
    for (int q = 0; q < 4; ++q) *(f32x4*)(up + 4 * q) = (f32x4){a[4 * q], a[4 * q + 1], a[4 * q + 2], a[4 * q + 3]};
    __syncthreads();
}
__device__ __forceinline__ void gla2_scan(const Args& A, int G, int tid) {
    const float* UC = (const float*)(A.ws + WS_UC); const float* GC = (const float*)(A.ws + WS_GC); float* SP = (float*)(A.ws + WS_SP);
    for (int e = blockIdx.x * 512 + tid; e < 8 * 8192; e += G * 512) {
        const int bh = e >> 13, kv = e & 8191, kk = kv & 63; float S = 0.f;
        for (int n0 = 0; n0 < NCHUNK; n0 += 8) { float uu[8], gg[8];
#pragma unroll
            for (int q = 0; q < 8; ++q) { const size_t unit = (size_t)bh * 128 + n0 + q; uu[q] = UC[unit * 8192 + kv]; gg[q] = GC[unit * 64 + kk]; }
#pragma unroll
            for (int q = 0; q < 8; ++q) { const size_t unit = (size_t)bh * 128 + n0 + q; SP[unit * 8192 + kv] = S; S = gg[q] * S + uu[q]; } }
    }
}
__device__ __forceinline__ void gla3_unit(const Args& A, int l, int unit, LAS unsigned char* lds, int tid) {
    const int bh = unit >> 7, n = unit & 127, b = bh >> 2, h = bh & 3; const size_t row0 = (size_t)b * SEQ + (size_t)n * 64;
    LAS float* bcL = (LAS float*)lds;
    LAS float* kL = bcL + 4096;
    LAS float* vL = kL + 4096;
    LAS float* attT = vL + 8192;
    LAS float* bcT = attT + 4096;
    LAS float* qT = bcT + 64 * 65;
    const bf16* QKVR = (const bf16*)(A.ws + WS_QKVR); const float* LAp = (const float*)(A.ws + WS_LA);
    const float* SP = (const float*)(A.ws + WS_SP) + (size_t)unit * 8192; bf16* Y = (bf16*)(A.ws + WS_Y);
    for (int p = tid; p < 1024; p += 512) { const int j = p >> 4, c = (p & 15) * 4; *(LAS f32x4*)(bcL + j * 64 + c) = *(const f32x4*)(LAp + (row0 + j) * 256 + h * 64 + c); }
    ld_tile_bf16(QKVR + row0 * 1536 + 256 + h * 64, 1536, 64, kL, tid);
    ld_tile_bf16(QKVR + row0 * 1536 + 512 + h * 128, 1536, 128, vL, tid);
    { const int j = tid >> 3, c = (tid & 7) * 8; const v4u w = *(const v4u*)(QKVR + (row0 + j) * 1536 + h * 64 + c);
      qT[(c + 0) * 65 + j] = bflo(w.x); qT[(c + 1) * 65 + j] = bfhi(w.x); qT[(c + 2) * 65 + j] = bflo(w.y); qT[(c + 3) * 65 + j] = bfhi(w.y);
      qT[(c + 4) * 65 + j] = bflo(w.z); qT[(c + 5) * 65 + j] = bfhi(w.z); qT[(c + 6) * 65 + j] = bflo(w.w); qT[(c + 7) * 65 + j] = bfhi(w.w); }
    __syncthreads();
    if (tid < 64) { float s = 0.f;
        for (int j = 0; j < 64; ++j) { s += bcL[j * 64 + tid]; bcL[j * 64 + tid] = s; bcT[tid * 65 + j] = s; } }
    __syncthreads();
    {
        const int i = tid & 63, jg = tid >> 6; float a[8];
#pragma unroll
        for (int jj = 0; jj < 8; ++jj) a[jj] = 0.f;
        for (int kk = 0; kk < 64; ++kk) { const float qi = qT[kk * 65 + i], bi = bcT[kk * 65 + i];
#pragma unroll
            for (int jj = 0; jj < 8; ++jj) { const int j = jg * 8 + jj; a[jj] += qi * kL[j * 64 + kk] * __expf(-__builtin_fabsf(bi - bcL[j * 64 + kk])); } }
#pragma unroll
        for (int jj = 0; jj < 8; ++jj) attT[(jg * 8 + jj) * 64 + i] = a[jj];
    }
    __syncthreads();
    { const int i = tid & 63, k0 = (tid >> 6) * 8;
#pragma unroll
      for (int c = 0; c < 8; ++c) qT[(k0 + c) * 65 + i] *= __expf(bcT[(k0 + c) * 65 + i]); }
    __syncthreads();
    const int i = tid >> 3, vv0 = (tid & 7) * 16; float o[16];
#pragma unroll
    for (int c = 0; c < 16; ++c) o[c] = 0.f;
    for (int j = 0; j < 64; ++j) { const float av = attT[j * 64 + i];
#pragma unroll
        for (int q = 0; q < 4; ++q) { const f32x4 x = *(const LAS f32x4*)(vL + j * 128 + vv0 + 4 * q); o[4 * q] += av * x.x; o[4 * q + 1] += av * x.y; o[4 * q + 2] += av * x.z; o[4 * q + 3] += av * x.w; } }
    for (int kk = 0; kk < 64; ++kk) { const float qf = qT[kk * 65 + i];
#pragma unroll
        for (int q = 0; q < 4; ++q) { const f32x4 x = *(const f32x4*)(SP + kk * 128 + vv0 + 4 * q); o[4 * q] += qf * x.x; o[4 * q + 1] += qf * x.y; o[4 * q + 2] += qf * x.z; o[4 * q + 3] += qf * x.w; } }
    float ss = 0.f;
#pragma unroll
    for (int c = 0; c < 16; ++c) ss += o[c] * o[c];
    ss += __shfl_xor(ss, 1); ss += __shfl_xor(ss, 2); ss += __shfl_xor(ss, 4);
    const float rstd = 1.0f / sqrtf(ss * (1.0f / DV) + EPS);
    const float* gn = A.in[I_GGLA] + (size_t)l * DGLA + h * DV + vv0;
    const bf16* rp = QKVR + (row0 + i) * 1536 + 1024 + h * DV + vv0;
    const v4u r0 = *(const v4u*)rp, r1 = *(const v4u*)(rp + 8);
    const float rr[16] = {bflo(r0.x), bfhi(r0.x), bflo(r0.y), bfhi(r0.y), bflo(r0.z), bfhi(r0.z), bflo(r0.w), bfhi(r0.w), bflo(r1.x), bfhi(r1.x), bflo(r1.y), bfhi(r1.y), bflo(r1.z), bfhi(r1.z), bflo(r1.w), bfhi(r1.w)};
    float y[16];
#pragma unroll
    for (int c = 0; c < 16; ++c) y[c] = o[c] * rstd * gn[c] * (rr[c] * fsigmoid(rr[c]));
    bf16* yp = Y + (row0 + i) * D + DCONV + h * DV + vv0;
    v4u w0, w1; w0.x = pk2(y[0], y[1]); w0.y = pk2(y[2], y[3]); w0.z = pk2(y[4], y[5]); w0.w = pk2(y[6], y[7]); w1.x = pk2(y[8], y[9]); w1.y = pk2(y[10], y[11]); w1.z = pk2(y[12], y[13]); w1.w = pk2(y[14], y[15]);
    *(v4u*)yp = w0; *(v4u*)(yp + 8) = w1;
    __syncthreads();
}


typedef short bf16x8 __attribute__((ext_vector_type(8)));
typedef float f32x16 __attribute__((ext_vector_type(16)));
constexpr int GP = 72;
constexpr int GPR = 136;
__device__ __forceinline__ bf16x8 ldfrag(const LAS bf16* tile, int rbase, int ks, int lane) { return *(const LAS bf16x8*)(tile + (rbase + (lane & 31)) * GP + 16 * ks + 8 * (lane >> 5)); }
template <int SH> __device__ __forceinline__ int rotc(int r, int c) { return (c + 8 * (r >> SH)) & 63; }
template <int SH> __device__ __forceinline__ bf16x8 ldfrag_rot(const LAS bf16* tile, int rbase, int ks, int lane) { const int r = rbase + (lane & 31); return *(const LAS bf16x8*)(tile + r * GP + rotc<SH>(r, 16 * ks + 8 * (lane >> 5))); }
__device__ __forceinline__ void chunk_cumsum(float (&x)[8], float (&bend)[8], LAS float* tot, int tid, int wave, int lane) {
#pragma unroll
    for (int c = 0; c < 8; ++c) {
        float t = __shfl_up(x[c], 8); if (lane >= 8) x[c] += t;
        t = __shfl_up(x[c], 16); if (lane >= 16) x[c] += t;
        t = __shfl_up(x[c], 32); if (lane >= 32) x[c] += t;
    }
    const int c8 = (tid & 7) * 8;
    if (lane >= 56) {
#pragma unroll
        for (int c = 0; c < 8; ++c) tot[wave * 64 + c8 + c] = x[c];
    }
    __syncthreads();
    float pre[8], all[8];
#pragma unroll
    for (int c = 0; c < 8; ++c) { pre[c] = 0.f; all[c] = 0.f; }
#pragma unroll
    for (int w = 0; w < 8; ++w) { const f32x4 t0 = *(const LAS f32x4*)(tot + w * 64 + c8), t1 = *(const LAS f32x4*)(tot + w * 64 + c8 + 4);
        const float t[8] = {t0.x, t0.y, t0.z, t0.w, t1.x, t1.y, t1.z, t1.w};
#pragma unroll
        for (int c = 0; c < 8; ++c) { all[c] += t[c]; if (w < wave) pre[c] += t[c]; } }
#pragma unroll
    for (int c = 0; c < 8; ++c) { x[c] += pre[c]; bend[c] = all[c]; }
}
__device__ __forceinline__ void unpack8(const v4u w, float (&f)[8]) { f[0] = bflo(w.x); f[1] = bfhi(w.x); f[2] = bflo(w.y); f[3] = bfhi(w.y); f[4] = bflo(w.z); f[5] = bfhi(w.z); f[6] = bflo(w.w); f[7] = bfhi(w.w); }
__device__ __forceinline__ v4u pack8(const float (&f)[8]) { v4u w; w.x = pk2(f[0], f[1]); w.y = pk2(f[2], f[3]); w.z = pk2(f[4], f[5]); w.w = pk2(f[6], f[7]); return w; }

__device__ __forceinline__ void gla1m_unit(const Args& A, int unit, LAS unsigned char* lds, int tid, int wave, int lane) {
    const int bh = unit >> 7, n = unit & 127, b = bh >> 2, h = bh & 3; const size_t row0 = (size_t)b * SEQ + (size_t)n * 64;
    LAS bf16* VT = (LAS bf16*)lds;
    LAS bf16* KDT = VT + 128 * GP;
    LAS float* tot = (LAS float*)(KDT + 64 * GP);
    const bf16* QKVR = (const bf16*)(A.ws + WS_QKVR); const float* LAp = (const float*)(A.ws + WS_LA);
    float* UC = (float*)(A.ws + WS_UC); float* GC = (float*)(A.ws + WS_GC);
    const int row = tid >> 3, c8 = (tid & 7) * 8, v16 = (tid & 7) * 16;
    const float* lap = LAp + (row0 + row) * 256 + h * 64 + c8;
    const f32x4 l0 = *(const f32x4*)lap, l1 = *(const f32x4*)(lap + 4);
    const bf16* rp = QKVR + (row0 + row) * 1536;
    const v4u kw = *(const v4u*)(rp + 256 + h * 64 + c8);
    const v4u vw0 = *(const v4u*)(rp + 512 + h * 128 + v16), vw1 = *(const v4u*)(rp + 512 + h * 128 + v16 + 8);
    float bc[8] = {l0.x, l0.y, l0.z, l0.w, l1.x, l1.y, l1.z, l1.w}, bend[8];
    chunk_cumsum(bc, bend, tot, tid, wave, lane);
    float kf[8]; unpack8(kw, kf);
#pragma unroll
    for (int c = 0; c < 8; ++c) KDT[(c8 + c) * GP + row] = (bf16)f2bf(kf[c] * __expf(bend[c] - bc[c]));
    { const unsigned vv[8] = {vw0.x, vw0.y, vw0.z, vw0.w, vw1.x, vw1.y, vw1.z, vw1.w};
#pragma unroll
      for (int c = 0; c < 8; ++c) { VT[(v16 + 2 * c) * GP + row] = (bf16)(vv[c] & 0xffffu); VT[(v16 + 2 * c + 1) * GP + row] = (bf16)(vv[c] >> 16); } }
    if (row == 63) {
#pragma unroll
        for (int c = 0; c < 8; ++c) GC[(size_t)unit * 64 + c8 + c] = __expf(bend[c]);
    }
    __syncthreads();
    const int mt = wave & 3, kb = wave >> 2;
    f32x16 acc;
#pragma unroll
    for (int r = 0; r < 16; ++r) acc[r] = 0.f;
#pragma unroll
    for (int ks = 0; ks < 4; ++ks) acc = __builtin_amdgcn_mfma_f32_32x32x16_bf16(ldfrag(VT, 32 * mt, ks, lane), ldfrag(KDT, 32 * kb, ks, lane), acc, 0, 0, 0);
    float* up = UC + (size_t)unit * 8192 + 32 * kb + (lane & 31);
#pragma unroll
    for (int r = 0; r < 16; ++r) { const int vc = 32 * mt + (r & 3) + 8 * (r >> 2) + 4 * (lane >> 5); up[vc * 64] = acc[r]; }
    __syncthreads();
}
__device__ __forceinline__ void gla3m_unit(const Args& A, int l, int unit, LAS unsigned char* lds, int tid, int wave, int lane) {
    const int bh = unit >> 7, n = unit & 127, b = bh >> 2, h = bh & 3; const size_t row0 = (size_t)b * SEQ + (size_t)n * 64;
    LAS bf16* QF = (LAS bf16*)lds;
    LAS bf16* QB = QF + 64 * GP;
    LAS bf16* KF = QB + 64 * GP;
    LAS bf16* KB = KF + 64 * GP;
    LAS bf16* ATT = KB + 64 * GP;
    LAS bf16* VT = ATT + 64 * GP;
    LAS bf16* ST = VT + 128 * GP;
    LAS bf16* RT = ST + 128 * GP;
    LAS float* tot = (LAS float*)(RT + 64 * GPR);
    LAS float* ssL = tot + 512;
    const bf16* QKVR = (const bf16*)(A.ws + WS_QKVR); const float* LAp = (const float*)(A.ws + WS_LA);
    const float* SP = (const float*)(A.ws + WS_SP) + (size_t)unit * 8192; bf16* Y = (bf16*)(A.ws + WS_Y);
    const int row = tid >> 3, c8 = (tid & 7) * 8, v16 = (tid & 7) * 16;
    const float* lap = LAp + (row0 + row) * 256 + h * 64 + c8;
    const f32x4 l0 = *(const f32x4*)lap, l1 = *(const f32x4*)(lap + 4);
    const bf16* rp = QKVR + (row0 + row) * 1536;
    const v4u qw = *(const v4u*)(rp + h * 64 + c8), kw = *(const v4u*)(rp + 256 + h * 64 + c8);
    const v4u vw0 = *(const v4u*)(rp + 512 + h * 128 + v16), vw1 = *(const v4u*)(rp + 512 + h * 128 + v16 + 8);
    const v4u rw0 = *(const v4u*)(rp + 1024 + h * 128 + v16), rw1 = *(const v4u*)(rp + 1024 + h * 128 + v16 + 8);
    { const int vc = tid >> 2, k0 = (tid & 3) * 16; const float* sp = SP + vc * 64 + k0;
      const f32x4 s0 = *(const f32x4*)sp, s1 = *(const f32x4*)(sp + 4), s2 = *(const f32x4*)(sp + 8), s3 = *(const f32x4*)(sp + 12);
      v4u w0, w1; w0.x = pk2(s0.x, s0.y); w0.y = pk2(s0.z, s0.w); w0.z = pk2(s1.x, s1.y); w0.w = pk2(s1.z, s1.w); w1.x = pk2(s2.x, s2.y); w1.y = pk2(s2.z, s2.w); w1.z = pk2(s3.x, s3.y); w1.w = pk2(s3.z, s3.w);
      *(LAS v4u*)(ST + vc * GP + k0) = w0; *(LAS v4u*)(ST + vc * GP + k0 + 8) = w1; }
    float bc[8] = {l0.x, l0.y, l0.z, l0.w, l1.x, l1.y, l1.z, l1.w}, bend[8];
    chunk_cumsum(bc, bend, tot, tid, wave, lane);
    {
        float qf[8], kf[8], a[8], c_[8], d_[8], e_[8]; unpack8(qw, qf); unpack8(kw, kf);
#pragma unroll
        for (int c = 0; c < 8; ++c) { const float e = __expf(bc[c]), ei = __expf(-bc[c]); a[c] = qf[c] * e; c_[c] = qf[c] * ei; d_[c] = kf[c] * e; e_[c] = kf[c] * ei; }
        *(LAS v4u*)(QF + row * GP + c8) = pack8(a); *(LAS v4u*)(QB + row * GP + c8) = pack8(c_); *(LAS v4u*)(KF + row * GP + c8) = pack8(d_); *(LAS v4u*)(KB + row * GP + c8) = pack8(e_);
    }
    { const unsigned vv[8] = {vw0.x, vw0.y, vw0.z, vw0.w, vw1.x, vw1.y, vw1.z, vw1.w};
#pragma unroll
      for (int c = 0; c < 8; ++c) { VT[(v16 + 2 * c) * GP + row] = (bf16)(vv[c] & 0xffffu); VT[(v16 + 2 * c + 1) * GP + row] = (bf16)(vv[c] >> 16); } }
    *(LAS v4u*)(RT + row * GPR + v16) = rw0; *(LAS v4u*)(RT + row * GPR + v16 + 8) = rw1;
    __syncthreads();
    if (wave < 4) {
        const int ib = wave >> 1, jb = wave & 1;
        f32x16 p1, p2;
#pragma unroll
        for (int r = 0; r < 16; ++r) { p1[r] = 0.f; p2[r] = 0.f; }
        if (ib >= jb) {
#pragma unroll
            for (int ks = 0; ks < 4; ++ks) p1 = __builtin_amdgcn_mfma_f32_32x32x16_bf16(ldfrag(KB, 32 * jb, ks, lane), ldfrag(QF, 32 * ib, ks, lane), p1, 0, 0, 0);
        }
        if (ib <= jb) {
#pragma unroll
            for (int ks = 0; ks < 4; ++ks) p2 = __builtin_amdgcn_mfma_f32_32x32x16_bf16(ldfrag(KF, 32 * jb, ks, lane), ldfrag(QB, 32 * ib, ks, lane), p2, 0, 0, 0);
        }
        const int i = 32 * ib + (lane & 31);
#pragma unroll
        for (int g = 0; g < 4; ++g) { const int j0 = 32 * jb + 8 * g + 4 * (lane >> 5); float v[4];
#pragma unroll
            for (int e = 0; e < 4; ++e) v[e] = (i >= j0 + e) ? p1[4 * g + e] : p2[4 * g + e];
            v2u w; w.x = pk2(v[0], v[1]); w.y = pk2(v[2], v[3]); *(LAS v2u*)(ATT + i * GP + j0) = w; }
    }
    __syncthreads();
    const int mt = wave & 3, nt = wave >> 2, i = 32 * nt + (lane & 31), hh = lane >> 5;
    f32x16 acc;
#pragma unroll
    for (int r = 0; r < 16; ++r) acc[r] = 0.f;
#pragma unroll
    for (int ks = 0; ks < 4; ++ks) acc = __builtin_amdgcn_mfma_f32_32x32x16_bf16(ldfrag(VT, 32 * mt, ks, lane), ldfrag(ATT, 32 * nt, ks, lane), acc, 0, 0, 0);
#pragma unroll
    for (int ks = 0; ks < 4; ++ks) acc = __builtin_amdgcn_mfma_f32_32x32x16_bf16(ldfrag(ST, 32 * mt, ks, lane), ldfrag(QF, 32 * nt, ks, lane), acc, 0, 0, 0);
    float ss = 0.f;
#pragma unroll
    for (int r = 0; r < 16; ++r) ss += acc[r] * acc[r];
    ss += __shfl_xor(ss, 32);
    if (hh == 0) ssL[mt * 64 + i] = ss;
    __syncthreads();
    const float rstd = 1.0f / sqrtf((ssL[i] + ssL[64 + i] + ssL[128 + i] + ssL[192 + i]) * (1.0f / DV) + EPS);
    const float* gn = A.in[I_GGLA] + (size_t)l * DGLA + h * DV;
#pragma unroll
    for (int g = 0; g < 4; ++g) { const int vc0 = 32 * mt + 8 * g + 4 * hh; const f32x4 gv = *(const f32x4*)(gn + vc0);
        const v2u rw = *(const LAS v2u*)(RT + i * GPR + vc0); const float r0 = bflo(rw.x), r1 = bfhi(rw.x), r2 = bflo(rw.y), r3 = bfhi(rw.y);
        const float y0 = acc[4 * g] * rstd * gv.x * (r0 * fsigmoid(r0)), y1 = acc[4 * g + 1] * rstd * gv.y * (r1 * fsigmoid(r1)), y2 = acc[4 * g + 2] * rstd * gv.z * (r2 * fsigmoid(r2)), y3 = acc[4 * g + 3] * rstd * gv.w * (r3 * fsigmoid(r3));
        v2u w; w.x = pk2(y0, y1); w.y = pk2(y2, y3); *(LAS v2u*)(RT + i * GPR + vc0) = w; }
    __syncthreads();
    { bf16* yp = Y + toff((int)row0 + row, DCONV + h * DV + v16, D); *(v4u*)yp = *(const LAS v4u*)(RT + row * GPR + v16); *(v4u*)(yp + 8) = *(const LAS v4u*)(RT + row * GPR + v16 + 8); }
    __syncthreads();
}


__device__ __forceinline__ void chunk_cumsum2(float (&x)[8], float (&bend)[8], LAS float* tile, LAS float* tot, int tid, int wave, int lane) {
    const int row = tid >> 3, c8 = (tid & 7) * 8;
    *(LAS f32x4*)(tile + row * 64 + c8) = (f32x4){x[0], x[1], x[2], x[3]}; *(LAS f32x4*)(tile + row * 64 + c8 + 4) = (f32x4){x[4], x[5], x[6], x[7]};
    __syncthreads();
    { LAS float* p = tile + (wave * 8) * 64 + lane; float v[8];
#pragma unroll
      for (int i = 0; i < 8; ++i) v[i] = p[i * 64];
#pragma unroll
      for (int i = 1; i < 8; ++i) v[i] += v[i - 1];
#pragma unroll
      for (int i = 0; i < 8; ++i) p[i * 64] = v[i];
      tot[wave * 64 + lane] = v[7]; }
    __syncthreads();
    const f32x4 a0 = *(const LAS f32x4*)(tile + row * 64 + c8), a1 = *(const LAS f32x4*)(tile + row * 64 + c8 + 4);
    float pre[8], all[8];
#pragma unroll
    for (int c = 0; c < 8; ++c) { pre[c] = 0.f; all[c] = 0.f; }
#pragma unroll
    for (int w = 0; w < 8; ++w) { const f32x4 t0 = *(const LAS f32x4*)(tot + w * 64 + c8), t1 = *(const LAS f32x4*)(tot + w * 64 + c8 + 4);
        const float t[8] = {t0.x, t0.y, t0.z, t0.w, t1.x, t1.y, t1.z, t1.w};
#pragma unroll
        for (int c = 0; c < 8; ++c) { all[c] += t[c]; if (w < wave) pre[c] += t[c]; } }
    const float loc[8] = {a0.x, a0.y, a0.z, a0.w, a1.x, a1.y, a1.z, a1.w};
#pragma unroll
    for (int c = 0; c < 8; ++c) { x[c] = loc[c] + pre[c]; bend[c] = all[c]; }
}
template <int SA, int SB> __device__ __forceinline__ f32x16 mma_k64(const LAS bf16* TA, int ra, const LAS bf16* TB, int rb, f32x16 acc, int lane) {
    bf16x8 a[4], b[4];
#pragma unroll
    for (int ks = 0; ks < 4; ++ks) { if constexpr (SA < 0) a[ks] = ldfrag(TA, ra, ks, lane); else a[ks] = ldfrag_rot<SA>(TA, ra, ks, lane);
                                     if constexpr (SB < 0) b[ks] = ldfrag(TB, rb, ks, lane); else b[ks] = ldfrag_rot<SB>(TB, rb, ks, lane); }
#pragma unroll
    for (int ks = 0; ks < 4; ++ks) acc = __builtin_amdgcn_mfma_f32_32x32x16_bf16(a[ks], b[ks], acc, 0, 0, 0);
    return acc;
}
#define GLA_LOAD1(c_) do { const size_t r_ = rowg + (size_t)(c_) * 64 + row; const float* lap_ = LAp + r_ * 256 + h * 64 + c8; l0 = *(const f32x4*)lap_; l1 = *(const f32x4*)(lap_ + 4); \
        const bf16* rp_ = QKVR + r_ * 1536; kw = *(const v4u*)(rp_ + 256 + h * 64 + c8); vw0 = *(const v4u*)(rp_ + 512 + h * 128 + v16); vw1 = *(const v4u*)(rp_ + 512 + h * 128 + v16 + 8); } while (0)
__device__ __forceinline__ void gla_p1_unit(const Args& A, int unit, LAS unsigned char* lds, int tid, int wave, int lane) {
    const int bh = unit >> 5, grp = unit & 31, b = bh >> 2, h = bh & 3; const size_t rowg = (size_t)b * SEQ + (size_t)grp * 256;
    LAS bf16* VT = (LAS bf16*)lds;
    LAS bf16* KDT = VT + 128 * GP;
    LAS float* tot = (LAS float*)(KDT + 64 * GP);
    LAS float* gL = tot + 512;
    LAS float* cst = gL + 64;
    const bf16* QKVR = (const bf16*)(A.ws + WS_QKVR); const float* LAp = (const float*)(A.ws + WS_LA);
    float* UG = (float*)(A.ws + WS_UC); float* GG = (float*)(A.ws + WS_GC);
    const int row = tid >> 3, c8 = (tid & 7) * 8, v16 = (tid & 7) * 16;
    const int mt = wave & 3, kb = wave >> 2;
    f32x16 acc;
#pragma unroll
    for (int r = 0; r < 16; ++r) acc[r] = 0.f;
    float gprod[8];
#pragma unroll
    for (int c = 0; c < 8; ++c) gprod[c] = 1.f;
    f32x4 l0, l1; v4u kw, vw0, vw1;
    GLA_LOAD1(0);
#pragma unroll
    for (int ch = 0; ch < 4; ++ch) {
        float bc[8] = {l0.x, l0.y, l0.z, l0.w, l1.x, l1.y, l1.z, l1.w}, bend[8]; const v4u kwc = kw, v0c = vw0, v1c = vw1;
        if (ch < 3) GLA_LOAD1(ch + 1);
        chunk_cumsum2(bc, bend, cst, tot, tid, wave, lane);
        float kf[8]; unpack8(kwc, kf);
#pragma unroll
        for (int c = 0; c < 8; ++c) KDT[(c8 + c) * GP + rotc<3>(c8 + c, row)] = (bf16)f2bf(kf[c] * __expf(bend[c] - bc[c]));
        { const unsigned vv[8] = {v0c.x, v0c.y, v0c.z, v0c.w, v1c.x, v1c.y, v1c.z, v1c.w};
#pragma unroll
          for (int c = 0; c < 8; ++c) { VT[(v16 + 2 * c) * GP + rotc<4>(v16 + 2 * c, row)] = (bf16)(vv[c] & 0xffffu); VT[(v16 + 2 * c + 1) * GP + rotc<4>(v16 + 2 * c + 1, row)] = (bf16)(vv[c] >> 16); } }
        if (row == 63) {
#pragma unroll
            for (int c = 0; c < 8; ++c) { const float g = __expf(bend[c]); gL[c8 + c] = g; gprod[c] *= g; }
        }
        __syncthreads();
        const float gk = gL[32 * kb + (lane & 31)];
#pragma unroll
        for (int r = 0; r < 16; ++r) acc[r] *= gk;
        acc = mma_k64<4, 3>(VT, 32 * mt, KDT, 32 * kb, acc, lane);
    }
    float* up = UG + (size_t)unit * 8192 + 32 * kb + (lane & 31);
#pragma unroll
    for (int r = 0; r < 16; ++r) { const int vc = 32 * mt + (r & 3) + 8 * (r >> 2) + 4 * (lane >> 5); up[vc * 64] = acc[r]; }
    if (row == 63) {
#pragma unroll
        for (int c = 0; c < 8; ++c) GG[(size_t)unit * 64 + c8 + c] = gprod[c];
    }
    __syncthreads();
}
__device__ __forceinline__ void gla_scan2(const Args& A, int G, int tid) {
    const float* UG = (const float*)(A.ws + WS_UC); const float* GG = (const float*)(A.ws + WS_GC); float* SS = (float*)(A.ws + WS_SP);
    const int gthreads = G * 256;
    for (int e = blockIdx.x * 256 + (tid & 255); e < 8 * 8192; e += gthreads) {
        if (tid >= 256) continue;
        const int bh = e >> 13, kv = e & 8191, kk = kv & 63; float S = 0.f;
        float uu[32], gg[32];
#pragma unroll
        for (int q = 0; q < 32; ++q) { const size_t unit = (size_t)bh * 32 + q; uu[q] = UG[unit * 8192 + kv]; gg[q] = GG[unit * 64 + kk]; }
#pragma unroll
        for (int q = 0; q < 32; ++q) { const size_t unit = (size_t)bh * 32 + q; SS[unit * 8192 + kv] = S; S = gg[q] * S + uu[q]; }
    }
}
#define GLA_LOAD2(c_) do { const size_t r_ = rowg + (size_t)(c_) * 64 + row; const float* lap_ = LAp + r_ * 256 + h * 64 + c8; l0 = *(const f32x4*)lap_; l1 = *(const f32x4*)(lap_ + 4); \
        const bf16* rp_ = QKVR + r_ * 1536; qw = *(const v4u*)(rp_ + h * 64 + c8); kw = *(const v4u*)(rp_ + 256 + h * 64 + c8); \
        vw0 = *(const v4u*)(rp_ + 512 + h * 128 + v16); vw1 = *(const v4u*)(rp_ + 512 + h * 128 + v16 + 8); rw0 = *(const v4u*)(rp_ + 1024 + h * 128 + v16); rw1 = *(const v4u*)(rp_ + 1024 + h * 128 + v16 + 8); } while (0)
__device__ __forceinline__ void gla_p2_unit(const Args& A, int l, int unit, LAS unsigned char* lds, int tid, int wave, int lane) {
    const int bh = unit >> 5, grp = unit & 31, b = bh >> 2, h = bh & 3; const size_t rowg = (size_t)b * SEQ + (size_t)grp * 256;
    LAS bf16* QF = (LAS bf16*)lds;
    LAS bf16* QB = QF + 64 * GP;
    LAS bf16* KF = QB + 64 * GP;
    LAS bf16* KB = KF + 64 * GP;
    LAS bf16* ATT = KB + 64 * GP;
    LAS bf16* KDT = ATT + 64 * GP;
    LAS bf16* VT = KDT + 64 * GP;
    LAS bf16* ST = VT + 128 * GP;
    LAS bf16* RT = ST + 128 * GP;
    LAS float* tot = (LAS float*)(RT + 64 * GPR);
    LAS float* ssL = tot + 512;
    LAS float* gL = ssL + 256;
    LAS float* cst = gL + 64;
    const bf16* QKVR = (const bf16*)(A.ws + WS_QKVR); const float* LAp = (const float*)(A.ws + WS_LA);
    const float* SS = (const float*)(A.ws + WS_SP) + (size_t)unit * 8192; bf16* Y = (bf16*)(A.ws + WS_Y);
    const int row = tid >> 3, c8 = (tid & 7) * 8, v16 = (tid & 7) * 16;
    const int vb = wave & 3, kb = wave >> 2, hh = lane >> 5;
    const int mt = wave & 3, nt = wave >> 2, i = 32 * nt + (lane & 31);
    f32x16 X;
    { const float* sp = SS + (size_t)(32 * vb + (lane & 31)) * 64 + 32 * kb + 4 * hh;
#pragma unroll
      for (int g = 0; g < 4; ++g) { const f32x4 t = *(const f32x4*)(sp + 8 * g); X[4 * g] = t.x; X[4 * g + 1] = t.y; X[4 * g + 2] = t.z; X[4 * g + 3] = t.w; } }
    f32x4 l0, l1; v4u qw, kw, vw0, vw1, rw0, rw1;
    GLA_LOAD2(0);
    const float* gn = A.in[I_GGLA] + (size_t)l * DGLA + h * DV;
    f32x4 gnv[4];
#pragma unroll
    for (int g = 0; g < 4; ++g) gnv[g] = *(const f32x4*)(gn + 32 * mt + 8 * g + 4 * hh);
#pragma unroll 1
    for (int ch = 0; ch < 4; ++ch) {
        float bc[8] = {l0.x, l0.y, l0.z, l0.w, l1.x, l1.y, l1.z, l1.w}, bend[8];
        const v4u qwc = qw, kwc = kw, v0c = vw0, v1c = vw1, r0c = rw0, r1c = rw1;
        if (ch < 3) GLA_LOAD2(ch + 1);
        chunk_cumsum2(bc, bend, cst, tot, tid, wave, lane);
        {
            float qf[8], kf[8], a[8], c_[8], d_[8], e_[8]; unpack8(qwc, qf); unpack8(kwc, kf);
#pragma unroll
            for (int c = 0; c < 8; ++c) { const float e = __expf(bc[c]), ei = __expf(-bc[c]); a[c] = qf[c] * e; c_[c] = qf[c] * ei; d_[c] = kf[c] * e; e_[c] = kf[c] * ei;
                KDT[(c8 + c) * GP + rotc<3>(c8 + c, row)] = (bf16)f2bf(kf[c] * __expf(bend[c] - bc[c])); }
            *(LAS v4u*)(QF + row * GP + c8) = pack8(a); *(LAS v4u*)(QB + row * GP + c8) = pack8(c_); *(LAS v4u*)(KF + row * GP + c8) = pack8(d_); *(LAS v4u*)(KB + row * GP + c8) = pack8(e_);
        }
        { const unsigned vv[8] = {v0c.x, v0c.y, v0c.z, v0c.w, v1c.x, v1c.y, v1c.z, v1c.w};
#pragma unroll
          for (int c = 0; c < 8; ++c) { VT[(v16 + 2 * c) * GP + rotc<4>(v16 + 2 * c, row)] = (bf16)(vv[c] & 0xffffu); VT[(v16 + 2 * c + 1) * GP + rotc<4>(v16 + 2 * c + 1, row)] = (bf16)(vv[c] >> 16); } }
        *(LAS v4u*)(RT + row * GPR + v16) = r0c; *(LAS v4u*)(RT + row * GPR + v16 + 8) = r1c;
        if (row == 63) {
#pragma unroll
            for (int c = 0; c < 8; ++c) gL[c8 + c] = __expf(bend[c]);
        }
        {
            LAS bf16* sp = ST + (32 * vb + (lane & 31)) * GP + 32 * kb + 4 * hh;
#pragma unroll
            for (int g = 0; g < 4; ++g) { v2u w; w.x = pk2(X[4 * g], X[4 * g + 1]); w.y = pk2(X[4 * g + 2], X[4 * g + 3]); *(LAS v2u*)(sp + 8 * g) = w; }
        }
        __syncthreads();
        if (wave < 4) {
            const int ib = wave >> 1, jb = wave & 1;
            f32x16 p1, p2;
#pragma unroll
            for (int r = 0; r < 16; ++r) { p1[r] = 0.f; p2[r] = 0.f; }
            if (ib >= jb) {
                p1 = mma_k64<-1, -1>(KB, 32 * jb, QF, 32 * ib, p1, lane);
            }
            if (ib <= jb) {
                p2 = mma_k64<-1, -1>(KF, 32 * jb, QB, 32 * ib, p2, lane);
            }
            const int ia = 32 * ib + (lane & 31);
#pragma unroll
            for (int g = 0; g < 4; ++g) { const int j0 = 32 * jb + 8 * g + 4 * hh; float v[4];
#pragma unroll
                for (int e = 0; e < 4; ++e) v[e] = (ia >= j0 + e) ? p1[4 * g + e] : p2[4 * g + e];
                v2u w; w.x = pk2(v[0], v[1]); w.y = pk2(v[2], v[3]); *(LAS v2u*)(ATT + ia * GP + j0) = w; }
        }
        {
#pragma unroll
            for (int g = 0; g < 4; ++g) { const f32x4 gq = *(const LAS f32x4*)(gL + 32 * kb + 8 * g + 4 * hh); X[4 * g] *= gq.x; X[4 * g + 1] *= gq.y; X[4 * g + 2] *= gq.z; X[4 * g + 3] *= gq.w; }
            X = mma_k64<3, 4>(KDT, 32 * kb, VT, 32 * vb, X, lane);
        }
        __syncthreads();
        f32x16 acc;
#pragma unroll
        for (int r = 0; r < 16; ++r) acc[r] = 0.f;
        acc = mma_k64<4, -1>(VT, 32 * mt, ATT, 32 * nt, acc, lane);
        acc = mma_k64<-1, -1>(ST, 32 * mt, QF, 32 * nt, acc, lane);
        float ss = 0.f;
#pragma unroll
        for (int r = 0; r < 16; ++r) ss += acc[r] * acc[r];
        ss += __shfl_xor(ss, 32);
        if (hh == 0) ssL[mt * 64 + i] = ss;
        __syncthreads();
        const float rstd = 1.0f / sqrtf((ssL[i] + ssL[64 + i] + ssL[128 + i] + ssL[192 + i]) * (1.0f / DV) + EPS);
#pragma unroll
        for (int g = 0; g < 4; ++g) { const int vc0 = 32 * mt + 8 * g + 4 * hh; const f32x4 gv = gnv[g];
            const v2u rw = *(const LAS v2u*)(RT + i * GPR + vc0); const float r0 = bflo(rw.x), r1 = bfhi(rw.x), r2 = bflo(rw.y), r3 = bfhi(rw.y);
            const float y0 = acc[4 * g] * rstd * gv.x * (r0 * fsigmoid(r0)), y1 = acc[4 * g + 1] * rstd * gv.y * (r1 * fsigmoid(r1)), y2 = acc[4 * g + 2] * rstd * gv.z * (r2 * fsigmoid(r2)), y3 = acc[4 * g + 3] * rstd * gv.w * (r3 * fsigmoid(r3));
            v2u w; w.x = pk2(y0, y1); w.y = pk2(y2, y3); *(LAS v2u*)(RT + i * GPR + vc0) = w; }
        __syncthreads();
        { bf16* yp = Y + toff((int)(rowg + (size_t)ch * 64) + row, DCONV + h * DV + v16, D); *(v4u*)yp = *(const LAS v4u*)(RT + row * GPR + v16); *(v4u*)(yp + 8) = *(const LAS v4u*)(RT + row * GPR + v16 + 8); }
    }
    __syncthreads();
}

constexpr int NPHASES = 2 + 2 * 9 + 1 + (PROBE_KIND == 1 ? 20 : PROBE_KIND == 2 ? 1 : PROBE_KIND == 3 ? 4 : PROBE_KIND == 4 ? 2 : PROBE_KIND == 5 ? 6 : PROBE_KIND == 7 ? 4 : PROBE_KIND == 8 ? 2 : PROBE_KIND == 9 ? 1 : (PROBE_KIND == 10 || PROBE_KIND == 11) ? 4 : (PROBE_KIND >= 12 && PROBE_KIND <= 15) ? 2 : 0);
__global__ void __launch_bounds__(512, 2) fwd_kernel(Args args) {
    extern __shared__ __attribute__((aligned(16))) unsigned char lds_raw[];
    LAS unsigned char* lds = (LAS unsigned char*)lds_raw;
    volatile LAS unsigned* MISC = (volatile LAS unsigned*)(lds + MISC_OFF);
    const int G = gridDim.x; const int bx = blockIdx.x; const int vcu = (G % 8 == 0) ? (bx % 8) * (G / 8) + bx / 8 : bx;
    const int NGW = G * 8;
    unsigned char* ws = args.ws;
    for (int u = threadIdx.x; u < (LDS_BYTES - RING_BYTES) / 4; u += 512) ((LAS unsigned*)(lds + RING_BYTES))[u] = 0u;
    __syncthreads();
    XcdBarrier bar; bar.bar = (unsigned*)(ws + WS_CTL) + CW_BAR; bar.x = 0; bar.st = nullptr;
    if (N_LAUNCH_MODE == 0) bar = xcd_barrier_post((unsigned*)(ws + WS_CTL) + CW_BAR, MISC + 8);
    const int lo = args.ph_lo, hi = args.ph_hi;
    int ph = 0;
#define PH_BEGIN if (lo <= ph && ph < hi) { int tid = threadIdx.x; asm volatile("" : "+v"(tid)); const int lane = tid & 63, wave = __builtin_amdgcn_readfirstlane(tid >> 6), gw = vcu * 8 + wave; (void)lane; (void)gw;
#define PH_END   if (N_LAUNCH_MODE == 0 && ph + 1 < hi) xcd_barrier(bar); } ++ph;

    float* X = args.out;
    const float* MOD = (const float*)(ws + WS_MOD);
    bf16* H = (bf16*)(ws + WS_H); bf16* ACT = (bf16*)(ws + WS_ACT); bf16* Y = (bf16*)(ws + WS_Y);

    for (int rep = 0; rep < (PROBE_KIND == 2 ? 2 : 1); ++rep) { PH_BEGIN p0_prologue(args, lds, vcu, G, tid, wave, lane); PH_END }
    if (PROBE_KIND == 1) for (int rep = 0; rep < 20; ++rep) { PH_BEGIN PH_END }
    for (int rep = 0; rep < (PROBE_KIND == 9 ? 2 : 1); ++rep) { PH_BEGIN p0b_phase(args, lds, G, tid, wave, lane, gw, NGW); PH_END }

    const float* SSQ = (const float*)(ws + WS_SSQ); const float* GS = (const float*)(ws + WS_GS); const float* CB = (const float*)(ws + WS_CB);
#pragma nounroll
    for (int l = 0; l < 2; ++l) {
        const bf16* WL = (const bf16*)(ws + WS_W) + (size_t)l * WL_ELEMS;
#pragma nounroll
        for (int f = 0; f < 2; ++f) {
            const float* xin = (l == 0 && f == 0) ? args.in[I_X] : X;
            const int mo = l * MODL + (f == 0 ? 0 : 6) * D;
            for (int rep = 0; rep < (PROBE_KIND == 3 ? 2 : 1); ++rep) {
            PH_BEGIN { pg8::Gemm g{H, WL + (f == 0 ? WL_FF1IN : WL_FF2IN), M, 2 * DFF, D}; pg8::StaticOrder S; S.init(M, 2 * DFF, G, bx);
                pg8::EpiSwiGLU E{ACT, SSQ, CB + (size_t)(l * 2) * CBROWS + (f == 0 ? CB_J0 : CB_J2), DFF, 0}; pg8::gemm_phase<pg8::EpiSwiGLU, pg8::StaticOrder, true, true>(lds, g, S, E); } PH_END }
            if (PROBE_KIND == 10) { PH_BEGIN { pg8::Gemm g{ACT, WL + (f == 0 ? WL_FF1OUT : WL_FF2OUT), M, D, DFF}; pg8::StaticOrder S; S.init(M, D, G, bx);
                pg8::EpiNull E{0}; pg8::gemm_phase<pg8::EpiNull, pg8::StaticOrder, true, true>(lds, g, S, E); } PH_END }
            if (PROBE_KIND == 11) { PH_BEGIN { pg8::Gemm g{H, WL + (f == 0 ? WL_FF1IN : WL_FF2IN), M, 2 * DFF, D}; pg8::StaticOrder S; S.init(M, 2 * DFF, G, bx);
                pg8::EpiNull E{0}; pg8::gemm_phase<pg8::EpiNull, pg8::StaticOrder, true, true>(lds, g, S, E); } PH_END }
            for (int rep = (PROBE_KIND == 7 ? 0 : 1); rep < 2; ++rep) {
            PH_BEGIN { pg8::Gemm g{ACT, WL + (f == 0 ? WL_FF1OUT : WL_FF2OUT), M, D, DFF}; pg8::StaticOrder S; S.init(M, D, G, bx);
                const int jn = (f == 0) ? l * 3 + 1 : (l == 0 ? 3 : 0);
                pg8::EpiResid E{xin, rep == 0 ? (float*)(ws + WS_Y) : X, MOD + mo + 2 * D, H, GS + (size_t)(jn * 2) * D, (float*)(ws + WS_SSQ), D, 0.5f};
                pg8::gemm_phase<pg8::EpiResid, pg8::StaticOrder, true, true>(lds, g, S, E); } PH_END }
            if (f == 0) {
                const int mm = l * MODL + 3 * D;
                for (int rep = 0; rep < (PROBE_KIND == 4 ? 2 : 1); ++rep) {
                PH_BEGIN { pg8::Gemm g{H, WL + WL_WIN, M, NIN, D}; pg8::StaticOrder S; S.init(M, NIN, G, bx);
                    pg8::EpiMix E{(bf16*)(ws + WS_U), (bf16*)(ws + WS_QKVR), (float*)(ws + WS_LA), args.in[I_BGATE] + l * 256, SSQ, CB + (size_t)(l * 2) * CBROWS + CB_J1};
                    pg8::gemm_phase<pg8::EpiMix, pg8::StaticOrder, true, true>(lds, g, S, E); } PH_END }
                if (PROBE_KIND == 12) { PH_BEGIN { for (int u = vcu; u < 512; u += G) conv_unit(args, l, u, lds, tid, wave, lane); } PH_END }
                if (PROBE_KIND == 13) { PH_BEGIN { for (int u = vcu; u < 256; u += G) gla_p1_unit(args, u, lds, tid, wave, lane); } PH_END }
                for (int rep = 0; rep < (PROBE_KIND == 5 ? 2 : 1); ++rep) {
                PH_BEGIN { for (int u = vcu; u < 512; u += G) conv_unit(args, l, u, lds, tid, wave, lane);
                           for (int u = vcu; u < 256; u += G) gla_p1_unit(args, u, lds, tid, wave, lane); } PH_END
                PH_BEGIN gla_scan2(args, G, tid); PH_END
                if (PROBE_KIND == 14) { PH_BEGIN gla_scan2(args, G, tid); PH_END }
                PH_BEGIN { for (int u = vcu; u < 256; u += G) gla_p2_unit(args, l, u, lds, tid, wave, lane); } PH_END
                if (PROBE_KIND == 15) { PH_BEGIN { for (int u = vcu; u < 256; u += G) gla_p2_unit(args, l, u, lds, tid, wave, lane); } PH_END } }
                for (int rep = (PROBE_KIND == 8 ? 0 : 1); rep < 2; ++rep) {
                PH_BEGIN { pg8::Gemm g{Y, WL + WL_WOUT, M, D, D}; pg8::StaticOrder S; S.init(M, D, G, bx);
                    pg8::EpiResid E{X, rep == 0 ? (float*)(ws + WS_ACT) : X, MOD + mm + 2 * D, H, GS + (size_t)((l * 3 + 2) * 2) * D, (float*)(ws + WS_SSQ), D, 1.0f};
                    pg8::gemm_phase<pg8::EpiResid, pg8::StaticOrder, true, true>(lds, g, S, E); } PH_END }
            }
        }
    }
    PH_BEGIN final_phase(X, args.in[I_GFIN], MOD, gw, NGW, lane); PH_END
#undef PH_BEGIN
#undef PH_END
}

extern "C" void kernel_launch(void* const* d_in, const int* in_sizes, int n_in, void* d_out, int out_size, void* d_ws, size_t ws_size, hipStream_t stream) {
    static int grid = 0;
    if (grid == 0) {
        if (n_in != 23 || in_sizes[0] != M * D || out_size != M * D || ws_size < WS_END) { fprintf(stderr, "kernel_launch: unexpected shapes (n_in %d, in0 %d, out %d, ws %zu)\n", n_in, n_in > 0 ? in_sizes[0] : -1, out_size, ws_size); grid = -1; return; }
        int dev = 0, cus = 0, per_cu = 0;
        if (hipGetDevice(&dev) != hipSuccess || hipDeviceGetAttribute(&cus, hipDeviceAttributeMultiprocessorCount, dev) != hipSuccess) { grid = -1; return; }
        if (hipFuncSetAttribute((const void*)fwd_kernel, hipFuncAttributeMaxDynamicSharedMemorySize, LDS_BYTES) != hipSuccess) { fprintf(stderr, "kernel_launch: hipFuncSetAttribute failed\n"); grid = -1; return; }
        if (hipOccupancyMaxActiveBlocksPerMultiprocessor(&per_cu, (const void*)fwd_kernel, 512, LDS_BYTES) != hipSuccess || per_cu < 1) fprintf(stderr, "kernel_launch: occupancy query reports %d\n", per_cu);
        (void)hipGetLastError();
        grid = cus;
    }
    if (grid < 0) return;
    if (hipMemsetAsync((char*)d_ws + WS_CTL, 0, CTL_ZERO_BYTES, stream) != hipSuccess) return;
    Args a{};
    for (int i = 0; i < 23; ++i) a.in[i] = (const float*)d_in[i];
    a.out = (float*)d_out; a.ws = (unsigned char*)d_ws;
    if (N_LAUNCH_MODE == 0) { a.ph_lo = 0; a.ph_hi = NPHASES; hipLaunchKernelGGL(fwd_kernel, dim3(grid), dim3(512), LDS_BYTES, stream, a); }
    else for (int p = 0; p < NPHASES; ++p) { a.ph_lo = p; a.ph_hi = p + 1; hipLaunchKernelGGL(fwd_kernel, dim3(grid), dim3(512), LDS_BYTES, stream, a); }
}
```

```cpp
#include <hip/hip_runtime.h>
#include <cstdio>
#include <cstdint>

#ifndef N_LAUNCH_MODE
#define N_LAUNCH_MODE 0
#endif
#ifndef PROBE_KIND
#define PROBE_KIND 0
#endif

constexpr int BATCH = 2, SEQ = 8192, D = 1024, M = BATCH * SEQ, DFF = 2816, DCONV = 512, CWID = 31, NH = 4, DK = 64, DV = 128, DGLA = 512;
constexpr int NIN_SRC = 2576;
constexpr int NIN = 2816;
constexpr int NCHUNK = SEQ / 64;
constexpr int MODL = 9 * D, MODN = 2 * MODL + 2 * D;
constexpr float EPS = 1e-6f;
constexpr int CB_J0 = 0, CB_J1 = 2 * 2816, CB_J2 = CB_J1 + 2816, CBROWS = CB_J2 + 2 * 2816;
constexpr float LOG2E = 1.4426950408889634f;

#define LAS __attribute__((address_space(3)))
typedef unsigned short bf16;
typedef unsigned v4u __attribute__((ext_vector_type(4)));
typedef unsigned v2u __attribute__((ext_vector_type(2)));
typedef float f32x4 __attribute__((ext_vector_type(4)));
typedef float f32x2 __attribute__((ext_vector_type(2)));

__device__ __forceinline__ unsigned f2bf(float f) { unsigned u = __builtin_bit_cast(unsigned, f); return (u + 0x7fffu + ((u >> 16) & 1u)) >> 16; }
__device__ __forceinline__ unsigned pk2(float lo, float hi) { return f2bf(lo) | (f2bf(hi) << 16); }
__device__ __forceinline__ float bf2f(unsigned short h) { return __builtin_bit_cast(float, (unsigned)h << 16); }
__device__ __forceinline__ float bflo(unsigned w) { return __builtin_bit_cast(float, w << 16); }
__device__ __forceinline__ float bfhi(unsigned w) { return __builtin_bit_cast(float, w & 0xffff0000u); }
__device__ __forceinline__ float fsigmoid(float x) { return __builtin_amdgcn_rcpf(1.0f + __builtin_amdgcn_exp2f(-LOG2E * x)); }
#ifndef TILED
#define TILED 0
#endif
__host__ __device__ __forceinline__ size_t toff(int row, int col, int K) {
#if TILED
    return ((size_t)(row >> 7) * (size_t)(K >> 6) + (size_t)(col >> 6)) * 8192 + (size_t)(row & 127) * 64 + (size_t)(col & 63);
#else
    return (size_t)row * (size_t)K + (size_t)col;
#endif
}
__device__ __forceinline__ float wave_sum(float v) {
#pragma unroll
    for (int o = 1; o < 64; o <<= 1) v += __shfl_xor(v, o);
    return v;
}

namespace pg8 {
#define PG8_LAS __attribute__((address_space(3)))
typedef unsigned short bf16_t;
typedef short bf16x8 __attribute__((ext_vector_type(8)));
typedef unsigned u32x4 __attribute__((ext_vector_type(4)));
constexpr int BM = 256, BK = 64, HALF = 128, HTB = HALF * BK * 2, STAGE_BYTES = 8 * HTB, NXCD = 8, WGM = 8;

__host__ __device__ __forceinline__ int lds_byte(int r, int c) { const int st = (r >> 4) * 2 + (c >> 5), rr = r & 15, cc = c & 31, ob = rr * 64 + cc * 2; return st * 1024 + (ob ^ (((ob >> 9) & 1) << 5)); }
__host__ __device__ __forceinline__ void stage_rc(int b, int& R, int& C) { const int st = b / 1024, sb = b % 1024, swz = sb ^ (((sb >> 9) & 1) << 5); R = (st >> 1) * 16 + swz / 64; C = (st & 1) * 32 + (swz % 64) / 2; }
__host__ __device__ __forceinline__ int perm32(int rho) { const int n = rho >> 4, i = rho & 15; return 8 * (i >> 2) + 4 * n + (i & 3); }

struct Unit { int pm, pn; };
struct Gemm { const bf16_t* A; const bf16_t* Bt; int M, N, K; };

struct StaticOrder {
    int nM, nN, nwg, G, c;
    __host__ __device__ void init(int M_, int N_, int G_, int c_) { nM = M_ / BM; nN = N_ / BM; nwg = nM * nN; G = G_; c = c_; }
    __host__ __device__ bool next(int i, Unit& u) const {
        const long L = (long)i * G + c; if (L >= nwg) return false;
        int wgid = (int)L; { const int q = nwg / NXCD, r = nwg % NXCD, xcd = wgid % NXCD, off = wgid / NXCD; wgid = (xcd < r ? xcd * (q + 1) : r * (q + 1) + (xcd - r) * q) + off; }
        const int nig = WGM * nN, gid = wgid / nig, fm = gid * WGM, gsz = (nM - fm) < WGM ? (nM - fm) : WGM;
        u.pm = fm + ((wgid % nig) % gsz); u.pn = (wgid % nig) / gsz; return true;
    }
    __device__ __forceinline__ void a_ready(const Unit&) const {}
    __device__ __forceinline__ void done(const Unit&) const {}
};

__device__ __forceinline__ unsigned cvt_pk_bf16(float lo, float hi) { unsigned r; asm volatile("v_cvt_pk_bf16_f32 %0, %1, %2" : "=v"(r) : "v"(lo), "v"(hi)); return r; }


__device__ __forceinline__ void rows_rstd(const float* ssq, int row0, int fq, float (&rs)[2][4]) {
    f32x4 p[2][4];
#pragma unroll
    for (int ai = 0; ai < 2; ++ai)
#pragma unroll
        for (int m = 0; m < 4; ++m) p[ai][m] = *(const f32x4*)(ssq + (size_t)(row0 + ai * 128 + m * 16) * 16 + 4 * fq);
#pragma unroll
    for (int ai = 0; ai < 2; ++ai)
#pragma unroll
        for (int m = 0; m < 4; ++m) { float s = (p[ai][m].x + p[ai][m].y) + (p[ai][m].z + p[ai][m].w); s += __shfl_xor(s, 16); s += __shfl_xor(s, 32); rs[ai][m] = 1.0f / sqrtf(s * (1.0f / 1024.0f) + 1e-6f); }
}
struct EpiSwiGLU {
    static constexpr bool PERM = true, AFTER_DRAIN = false;
    bf16_t* O; const float* ssq; const float* cb; int ldc; int pad_;
    __device__ __forceinline__ void operator()(const f32x4 (&acc)[2][2][4][2], const Unit& u, int wr, int wc, int fr, int fq) const {
        const int row0 = u.pm * BM + wr * 64 + fr, cin = wc * 32 + 8 * fq, col0 = u.pn * HALF + cin;
        const float* cp = cb + (size_t)(u.pm >> 5) * CBROWS + u.pn * BM + cin;
        f32x4 bv[2][2];
#pragma unroll
        for (int bj = 0; bj < 2; ++bj)
#pragma unroll
            for (int n = 0; n < 2; ++n) bv[bj][n] = *(const f32x4*)(cp + bj * HALF + 4 * n);
        float rsv[2][4]; rows_rstd(ssq, row0, fq, rsv);
#pragma unroll
        for (int ai = 0; ai < 2; ++ai)
#pragma unroll
            for (int m = 0; m < 4; ++m) {
                const int row = row0 + ai * HALF + m * 16; const float rs = rsv[ai][m];
                bf16_t* rowp = O + toff(row, col0, ldc);
                float v[8];
#pragma unroll
                for (int n = 0; n < 2; ++n)
#pragma unroll
                    for (int e = 0; e < 4; ++e) { const float g = acc[ai][0][m][n][e] * rs + bv[0][n][e], up = acc[ai][1][m][n][e] * rs + bv[1][n][e]; v[4 * n + e] = g * fsigmoid(g) * up; }
                u32x4 w; w.x = cvt_pk_bf16(v[0], v[1]); w.y = cvt_pk_bf16(v[2], v[3]); w.z = cvt_pk_bf16(v[4], v[5]); w.w = cvt_pk_bf16(v[6], v[7]);
                *(u32x4*)rowp = w;
                asm volatile("" ::: "memory");
            }
    }
};

struct EpiResid {
    static constexpr bool PERM = true, AFTER_DRAIN = false;
    const float* base; float* out; const float* gate; bf16_t* Hn; const float* gs; float* ssq; int ldc; float coef;
    __device__ __forceinline__ void operator()(const f32x4 (&acc)[2][2][4][2], const Unit& u, int wr, int wc, int fr, int fq) const {
        const int row0 = u.pm * BM + wr * 64 + fr, col0 = u.pn * BM + wc * 32 + 8 * fq;
        const float* gp = gate + (size_t)(u.pm >> 5) * MODN + col0;
        const float* sp = gs + (size_t)(u.pm >> 5) * 1024 + col0;
        f32x4 gv[2][2], sv[2][2];
#pragma unroll
        for (int bj = 0; bj < 2; ++bj)
#pragma unroll
            for (int n = 0; n < 2; ++n) { gv[bj][n] = *(const f32x4*)(gp + bj * HALF + n * 4) * coef; sv[bj][n] = *(const f32x4*)(sp + bj * HALF + n * 4); }
#pragma unroll
        for (int ai = 0; ai < 2; ++ai)
#pragma unroll
            for (int mp = 0; mp < 2; ++mp) {
                f32x4 bs[2][2][2];
#pragma unroll
                for (int mm = 0; mm < 2; ++mm)
#pragma unroll
                    for (int bj = 0; bj < 2; ++bj)
#pragma unroll
                        for (int n = 0; n < 2; ++n) bs[mm][bj][n] = *(const f32x4*)(base + (size_t)(row0 + ai * HALF + (2 * mp + mm) * 16) * ldc + col0 + bj * HALF + n * 4);
#pragma unroll
                for (int mm = 0; mm < 2; ++mm) {
                    const int m = 2 * mp + mm, row = row0 + ai * HALF + m * 16;
                    const size_t off = (size_t)row * ldc + col0; float q = 0.f;
#pragma unroll
                    for (int bj = 0; bj < 2; ++bj) {
                        f32x4 xn[2];
#pragma unroll
                        for (int n = 0; n < 2; ++n) { xn[n] = bs[mm][bj][n] + gv[bj][n] * acc[ai][bj][m][n];
                            *(f32x4*)(out + off + bj * HALF + n * 4) = xn[n];
                            q += (xn[n].x * xn[n].x + xn[n].y * xn[n].y) + (xn[n].z * xn[n].z + xn[n].w * xn[n].w); }
                        const f32x4 h0 = xn[0] * sv[bj][0], h1 = xn[1] * sv[bj][1];
                        u32x4 w; w.x = cvt_pk_bf16(h0.x, h0.y); w.y = cvt_pk_bf16(h0.z, h0.w); w.z = cvt_pk_bf16(h1.x, h1.y); w.w = cvt_pk_bf16(h1.z, h1.w);
                        *(u32x4*)(Hn + toff(row, col0 + bj * HALF, ldc)) = w;
                    }
                    q += __shfl_xor(q, 16); q += __shfl_xor(q, 32);
                    if (fq == 0) ssq[(size_t)row * 16 + u.pn * 4 + wc] = q;
                }
                asm volatile("" ::: "memory");
            }
    }
};

struct EpiNull {
    static constexpr bool PERM = true, AFTER_DRAIN = false; int dummy;
    __device__ __forceinline__ void operator()(const f32x4 (&acc)[2][2][4][2], const Unit&, int, int, int, int) const {
#pragma unroll
        for (int ai = 0; ai < 2; ++ai)
#pragma unroll
            for (int bj = 0; bj < 2; ++bj)
#pragma unroll
                for (int m = 0; m < 4; ++m)
#pragma unroll
                    for (int n = 0; n < 2; ++n) asm volatile("" :: "v"(acc[ai][bj][m][n]));
    }
};

struct EpiMix {
    static constexpr bool PERM = true, AFTER_DRAIN = false;
    bf16_t* U; bf16_t* QKVR; float* LA; const float* bgate; const float* ssq; const float* cb;
    __device__ __forceinline__ void operator()(const f32x4 (&acc_)[2][2][4][2], const Unit& u, int wr, int wc, int fr, int fq) const {
        const int row0 = u.pm * BM + wr * 64 + fr, cin = wc * 32 + 8 * fq;
        f32x4 acc[2][2][4][2];
        {
            const float* cp = cb + (size_t)(u.pm >> 5) * CBROWS + u.pn * BM + cin;
            f32x4 cv[2][2];
#pragma unroll
            for (int bj = 0; bj < 2; ++bj)
#pragma unroll
                for (int n = 0; n < 2; ++n) cv[bj][n] = *(const f32x4*)(cp + bj * HALF + 4 * n);
            float rsv[2][4]; rows_rstd(ssq, row0, fq, rsv);
#pragma unroll
            for (int ai = 0; ai < 2; ++ai)
#pragma unroll
                for (int m = 0; m < 4; ++m) { const float rs = rsv[ai][m];
#pragma unroll
                    for (int bj = 0; bj < 2; ++bj)
#pragma unroll
                        for (int n = 0; n < 2; ++n) acc[ai][bj][m][n] = acc_[ai][bj][m][n] * rs + cv[bj][n]; }
        }
        if (u.pn < 4) {
#pragma unroll
            for (int ai = 0; ai < 2; ++ai)
#pragma unroll
                for (int m = 0; m < 4; ++m) {
                    bf16_t* rowp = U + (size_t)(row0 + ai * HALF + m * 16) * DCONV + u.pn * HALF + cin;
                    float v[8];
#pragma unroll
                    for (int n = 0; n < 2; ++n)
#pragma unroll
                        for (int e = 0; e < 4; ++e) v[4 * n + e] = acc[ai][0][m][n][e] * fsigmoid(acc[ai][1][m][n][e]);
                    u32x4 w; w.x = cvt_pk_bf16(v[0], v[1]); w.y = cvt_pk_bf16(v[2], v[3]); w.z = cvt_pk_bf16(v[4], v[5]); w.w = cvt_pk_bf16(v[6], v[7]);
                    *(u32x4*)rowp = w;
                    asm volatile("" ::: "memory");
                }
        } else if (u.pn < 10) {
            const float sc = (u.pn == 4) ? 0.125f : 1.0f;
#pragma unroll
            for (int ai = 0; ai < 2; ++ai)
#pragma unroll
                for (int m = 0; m < 4; ++m) {
                    bf16_t* rowp = QKVR + (size_t)(row0 + ai * HALF + m * 16) * 1536 + (u.pn - 4) * BM + cin;
#pragma unroll
                    for (int bj = 0; bj < 2; ++bj) {
                        const f32x4 v0 = acc[ai][bj][m][0] * sc, v1 = acc[ai][bj][m][1] * sc;
                        u32x4 w; w.x = cvt_pk_bf16(v0[0], v0[1]); w.y = cvt_pk_bf16(v0[2], v0[3]); w.z = cvt_pk_bf16(v1[0], v1[1]); w.w = cvt_pk_bf16(v1[2], v1[3]);
                        *(u32x4*)(rowp + bj * HALF) = w;
                    }
                    asm volatile("" ::: "memory");
                }
        } else {
            f32x4 bv[2][2];
#pragma unroll
            for (int bj = 0; bj < 2; ++bj)
#pragma unroll
                for (int n = 0; n < 2; ++n) bv[bj][n] = *(const f32x4*)(bgate + bj * HALF + cin + 4 * n);
#pragma unroll
            for (int ai = 0; ai < 2; ++ai)
#pragma unroll
                for (int m = 0; m < 4; ++m) {
                    float* rowp = LA + (size_t)(row0 + ai * HALF + m * 16) * 256 + cin;
#pragma unroll
                    for (int bj = 0; bj < 2; ++bj)
#pragma unroll
                        for (int n = 0; n < 2; ++n) {
                            const f32x4 z = acc[ai][bj][m][n] + bv[bj][n]; f32x4 o;
#pragma unroll
                            for (int e = 0; e < 4; ++e) { const float az = __builtin_fabsf(z[e]); o[e] = (fminf(z[e], 0.f) - __logf(1.0f + __expf(-az))) * (1.0f / 16.0f); }
                            *(f32x4*)(rowp + bj * HALF + 4 * n) = o;
                            asm volatile("" ::: "memory");
                        }
                }
        }
    }
};

template <class Epi, class Sched, bool ALIGN_EPI = false, bool SP2 = false>
__device__ __forceinline__ void gemm_phase(PG8_LAS unsigned char* lds, const Gemm g, const Sched& S, const Epi& E) {
    int tid_ = threadIdx.x; asm volatile("" : "+v"(tid_));
    const char* gA = (const char*)g.A; const char* gB = (const char*)g.Bt; asm volatile("" : "+s"(gA), "+s"(gB));
    const int tid = tid_, wid = __builtin_amdgcn_readfirstlane(tid >> 6), lane = tid & 63, wr = wid >> 2, wc = wid & 3, fr = lane & 15, fq = lane >> 4;
    const int K = g.K, nt = K / BK;
    unsigned voffA[2], voffB[2];
#pragma unroll
    for (int i = 0; i < 2; ++i) { int R, C; stage_rc(tid * 16 + i * 8192, R, C); const int Rb = Epi::PERM ? ((R & ~31) + perm32(R & 31)) : R;
        voffA[i] = (unsigned)(R * (TILED ? 64 : K) + C) * 2u; voffB[i] = (unsigned)(Rb * (TILED ? 64 : K) + C) * 2u; }
    const size_t kstep = TILED ? (size_t)(HALF * BK * 2) : (size_t)(BK * 2);
    const size_t hstep = (size_t)HALF * K * 2;
    const size_t tstep = 2 * hstep;
    const unsigned ldsw = (unsigned)wid * 1024u;
    const int aoff = lds_byte(wr * 64 + fr, fq * 8), boff = lds_byte(wc * 32 + fr, fq * 8);
#define PG8_SA(b, h) (((b) * 2 + (h)) * HTB)
#define PG8_SB(b, h) ((4 + (b) * 2 + (h)) * HTB)
#define PG8_STAGE(bufoff, gbase, voff) do { _Pragma("unroll") for (int _i = 0; _i < 2; ++_i) \
        __builtin_amdgcn_global_load_lds((const unsigned*)((const char*)(gbase) + (voff)[_i]), (PG8_LAS unsigned*)(lds + (bufoff) + ldsw + _i * 8192), 16, 0, 0); } while (0)
#define PG8_LDA(dst, b, h) do { _Pragma("unroll") for (int m = 0; m < 4; ++m) _Pragma("unroll") for (int k = 0; k < 2; ++k) dst[m][k] = *(const PG8_LAS bf16x8*)(lds + PG8_SA(b, h) + aoff + m * 2048 + k * 1024); } while (0)
#define PG8_LDB(dst, b, h) do { _Pragma("unroll") for (int n = 0; n < 2; ++n) _Pragma("unroll") for (int k = 0; k < 2; ++k) dst[n][k] = *(const PG8_LAS bf16x8*)(lds + PG8_SB(b, h) + boff + n * 2048 + k * 1024); } while (0)
#define PG8_MMA(ai, bj, At, Bt) do { __builtin_amdgcn_s_setprio(1); _Pragma("unroll") for (int m = 0; m < 4; ++m) _Pragma("unroll") for (int n = 0; n < 2; ++n) _Pragma("unroll") for (int k = 0; k < 2; ++k) \
        acc[ai][bj][m][n] = __builtin_amdgcn_mfma_f32_16x16x32_bf16(Bt[n][k], At[m][k], acc[ai][bj][m][n], 0, 0, 0); __builtin_amdgcn_s_setprio(0); } while (0)
#define PG8_WAIT_V(n) asm volatile("s_waitcnt vmcnt(" #n ")" ::: "memory")
#define PG8_WAIT_L(n) asm volatile("s_waitcnt lgkmcnt(" #n ")" ::: "memory")
#define PG8_BAR __builtin_amdgcn_s_barrier()
#define PG8_SCHED __builtin_amdgcn_sched_barrier(0)
    Unit cur, nxt; int ui = 0;
    if (!S.next(0, cur)) return;
    f32x4 acc[2][2][4][2];
#pragma unroll
    for (int a = 0; a < 2; ++a)
#pragma unroll
        for (int b = 0; b < 2; ++b)
#pragma unroll
            for (int m = 0; m < 4; ++m)
#pragma unroll
                for (int n = 0; n < 2; ++n) acc[a][b][m][n] = (f32x4){0.f, 0.f, 0.f, 0.f};
    bf16x8 At[4][2], B0[2][2], B1[2][2];
    const char* cA = gA + (size_t)cur.pm * tstep; const char* cB = gB + (size_t)cur.pn * tstep;
    S.a_ready(cur);
    if constexpr (SP2) {
        PG8_STAGE(PG8_SB(0, 0), cB, voffB); PG8_STAGE(PG8_SB(0, 1), cB + hstep, voffB); PG8_STAGE(PG8_SA(0, 0), cA, voffA); PG8_STAGE(PG8_SA(0, 1), cA + hstep, voffA);
        if (wr == 1) PG8_BAR;
        PG8_WAIT_V(2); PG8_BAR;
        PG8_STAGE(PG8_SB(1, 0), cB + kstep, voffB); PG8_STAGE(PG8_SA(1, 0), cA + kstep, voffA); PG8_STAGE(PG8_SB(1, 1), cB + hstep + kstep, voffB);
        PG8_WAIT_V(6); PG8_BAR;
    } else {
        PG8_STAGE(PG8_SB(0, 0), cB, voffB); PG8_STAGE(PG8_SA(0, 0), cA, voffA); PG8_STAGE(PG8_SB(0, 1), cB + hstep, voffB); PG8_STAGE(PG8_SA(0, 1), cA + hstep, voffA);
        if (wr == 1) PG8_BAR;
        PG8_WAIT_V(4); PG8_BAR;
        PG8_STAGE(PG8_SB(1, 0), cB + kstep, voffB); PG8_STAGE(PG8_SA(1, 0), cA + kstep, voffA); PG8_STAGE(PG8_SB(1, 1), cB + hstep + kstep, voffB);
        PG8_WAIT_V(6); PG8_BAR;
    }
    for (;;) {
        const bool has_next = S.next(ui + 1, nxt);
        const char* nA = has_next ? gA + (size_t)nxt.pm * tstep : cA; const char* nB = has_next ? gB + (size_t)nxt.pn * tstep : cB;
        for (int t = 0; t < nt; t += 2) {
            const bool last = (t == nt - 2);
            const char* a1 = cA + (size_t)(t + 1) * kstep;
            const char* a2 = last ? nA : cA + (size_t)(t + 2) * kstep; const char* b2 = last ? nB : cB + (size_t)(t + 2) * kstep;
            const char* a3 = a2 + kstep; const char* b3 = b2 + kstep;
            if (last && has_next) S.a_ready(nxt);
            if constexpr (SP2) {
            PG8_LDB(B0, 0, 0); PG8_LDB(B1, 0, 1); PG8_SCHED; PG8_LDA(At, 0, 0); PG8_STAGE(PG8_SA(1, 1), a1 + hstep, voffA);
            PG8_WAIT_V(8); PG8_WAIT_L(0); PG8_BAR; PG8_MMA(0, 0, At, B0); PG8_MMA(0, 1, At, B1); PG8_BAR; PG8_SCHED;
            PG8_LDA(At, 0, 1); PG8_STAGE(PG8_SB(0, 0), b2, voffB); PG8_STAGE(PG8_SB(0, 1), b2 + hstep, voffB); PG8_STAGE(PG8_SA(0, 0), a2, voffA);
            PG8_WAIT_V(8); PG8_WAIT_L(0); PG8_BAR; PG8_MMA(1, 0, At, B0); PG8_MMA(1, 1, At, B1); PG8_BAR; PG8_SCHED;
            PG8_LDB(B0, 1, 0); PG8_LDB(B1, 1, 1); PG8_SCHED; PG8_LDA(At, 1, 0); PG8_STAGE(PG8_SA(0, 1), a2 + hstep, voffA);
            PG8_WAIT_V(8); PG8_WAIT_L(0); PG8_BAR; PG8_MMA(0, 0, At, B0); PG8_MMA(0, 1, At, B1); PG8_BAR; PG8_SCHED;
            PG8_LDA(At, 1, 1); PG8_STAGE(PG8_SB(1, 0), b3, voffB); PG8_STAGE(PG8_SB(1, 1), b3 + hstep, voffB); PG8_STAGE(PG8_SA(1, 0), a3, voffA);
            PG8_WAIT_V(8); PG8_WAIT_L(0); PG8_BAR; PG8_MMA(1, 0, At, B0); PG8_MMA(1, 1, At, B1); PG8_BAR; PG8_SCHED;
            } else {
            PG8_LDB(B0, 0, 0); PG8_SCHED; PG8_LDA(At, 0, 0); PG8_STAGE(PG8_SA(1, 1), a1 + hstep, voffA);
            PG8_WAIT_L(8); PG8_BAR; PG8_WAIT_L(0); PG8_MMA(0, 0, At, B0); PG8_BAR; PG8_SCHED;
            PG8_LDB(B1, 0, 1); PG8_STAGE(PG8_SB(0, 0), b2, voffB);
            PG8_BAR; PG8_WAIT_L(0); PG8_MMA(0, 1, At, B1); PG8_BAR;
            PG8_LDA(At, 0, 1); PG8_STAGE(PG8_SA(0, 0), a2, voffA);
            PG8_BAR; PG8_WAIT_L(0); PG8_MMA(1, 0, At, B0); PG8_BAR; PG8_SCHED;
            PG8_STAGE(PG8_SB(0, 1), b2 + hstep, voffB);
            PG8_WAIT_V(6); PG8_BAR; PG8_MMA(1, 1, At, B1); PG8_BAR;
            PG8_LDB(B0, 1, 0); PG8_SCHED; PG8_LDA(At, 1, 0); PG8_STAGE(PG8_SA(0, 1), a2 + hstep, voffA);
            PG8_WAIT_L(8); PG8_BAR; PG8_WAIT_L(0); PG8_MMA(0, 0, At, B0); PG8_BAR; PG8_SCHED;
            PG8_LDB(B1, 1, 1); PG8_STAGE(PG8_SB(1, 0), b3, voffB);
            PG8_BAR; PG8_WAIT_L(0); PG8_MMA(0, 1, At, B1); PG8_BAR;
            PG8_LDA(At, 1, 1); PG8_STAGE(PG8_SA(1, 0), a3, voffA);
            PG8_BAR; PG8_WAIT_L(0); PG8_MMA(1, 0, At, B0); PG8_BAR; PG8_SCHED;
            PG8_STAGE(PG8_SB(1, 1), b3 + hstep, voffB);
            PG8_WAIT_V(6); PG8_BAR; PG8_MMA(1, 1, At, B1); PG8_BAR;
            }
        }
        if constexpr (ALIGN_EPI) { if (wr == 0) PG8_BAR; }
        if constexpr (!Epi::AFTER_DRAIN) { E(acc, cur, wr, wc, fr, fq); S.done(cur); }
        if (!has_next) break;
#pragma unroll
        for (int a = 0; a < 2; ++a)
#pragma unroll
            for (int b = 0; b < 2; ++b)
#pragma unroll
                for (int m = 0; m < 4; ++m)
#pragma unroll
                    for (int n = 0; n < 2; ++n) acc[a][b][m][n] = (f32x4){0.f, 0.f, 0.f, 0.f};
        cur = nxt; cA = nA; cB = nB; ++ui;
        if constexpr (ALIGN_EPI) { if (wr == 1) PG8_BAR; }
    }
    PG8_WAIT_V(0);
    if constexpr (!ALIGN_EPI) { if (wr == 0) PG8_BAR; }
    PG8_BAR;
#undef PG8_SA
#undef PG8_SB
#undef PG8_STAGE
#undef PG8_LDA
#undef PG8_LDB
#undef PG8_MMA
#undef PG8_WAIT_V
#undef PG8_WAIT_L
#undef PG8_BAR
#undef PG8_SCHED
}
}

constexpr size_t MiB = 1u << 20;
constexpr size_t WS_CTL = 0, CTL_ZERO_BYTES = 1 * MiB;
constexpr size_t WS_MOD = 1 * MiB;
constexpr size_t WS_PART = 1 * MiB + 256 * 1024;
constexpr size_t WS_W = 3 * MiB;
constexpr size_t WL_FF1IN = 0, WL_FF1OUT = WL_FF1IN + (size_t)2 * DFF * D, WL_WIN = WL_FF1OUT + (size_t)D * DFF, WL_WOUT = WL_WIN + (size_t)NIN * D,
                 WL_FF2IN = WL_WOUT + (size_t)D * D, WL_FF2OUT = WL_FF2IN + (size_t)2 * DFF * D, WL_ELEMS = WL_FF2OUT + (size_t)D * DFF;
constexpr size_t WS_ACT = 84 * MiB;
constexpr size_t WS_U = WS_ACT, WS_QKVR = WS_ACT + 16 * MiB, WS_LA = WS_ACT + 64 * MiB;
constexpr size_t WS_H = 172 * MiB;
constexpr size_t WS_UC = WS_H;
constexpr size_t WS_Y = 204 * MiB;
constexpr size_t WS_SP = 236 * MiB;
constexpr size_t WS_GC = 268 * MiB;
constexpr size_t WS_SSQ = 268 * MiB + 512 * 1024;
constexpr size_t WS_GS = 2 * MiB + 512 * 1024;
constexpr size_t WS_CB = WS_GS + 64 * 1024;
constexpr size_t WS_END = 270 * MiB;
static_assert(WS_W + 2 * WL_ELEMS * 2 <= WS_ACT, "weights fit");
static_assert(WS_ACT + (size_t)M * DFF * 2 <= WS_H, "act fits");
constexpr int CW_BAR = 4096;

constexpr int RING_BYTES = 131072, MISC_OFF = RING_BYTES + 320, LDS_BYTES = 147456;

#define XB_TMO      128
#define XB_XCNT(j)  (256  + 64 * (j))
#define XB_XSUB(j)  (1280 + 64 * (j))
#define XB_XGEN(j)  (2304 + 64 * (j))
#define XB_TOP      3328
#define XB_TOPGEN   3392
#define XCD_BAR_WORDS 3456
#define XB_SPIN_CAP (1u << 18)
__device__ __forceinline__ unsigned xb_ld(unsigned* p)              { return __hip_atomic_load(p, __ATOMIC_RELAXED, __HIP_MEMORY_SCOPE_AGENT); }
__device__ __forceinline__ unsigned xb_add(unsigned* p, unsigned v) { return __hip_atomic_fetch_add(p, v, __ATOMIC_RELAXED, __HIP_MEMORY_SCOPE_AGENT); }
__device__ __forceinline__ unsigned xb_xcc_id() { return (unsigned)__builtin_amdgcn_s_getreg((3 << 11) | 20) & 0xFu; }
#define XB_SPIN(cond, bar) do { unsigned _sp = 0; while (cond) { __builtin_amdgcn_s_sleep(1); \
    if ((++_sp & 255u) == 0u) { if (xb_ld(&(bar)[XB_TMO])) break; if (_sp > XB_SPIN_CAP) { atomicAdd(&(bar)[XB_TMO], 1u); break; } } } } while (0)
struct XcdBarrier { unsigned* bar; unsigned x; volatile LAS unsigned* st; };
__device__ __forceinline__ XcdBarrier xcd_barrier_post(unsigned* bar, volatile LAS unsigned* st) {
    XcdBarrier b; b.bar = bar; b.x = xb_xcc_id(); b.st = st;
    if (threadIdx.x == 0) (void)xb_add(&bar[XB_XCNT(b.x)], 1u);
    return b;
}
__device__ __forceinline__ void xcd_barrier_complete(unsigned* bar, unsigned x, unsigned& nloc, unsigned& nx) {
    const unsigned G = gridDim.x * gridDim.y * gridDim.z;
    unsigned sum, cnt, mine, sp = 0u;
    for (;;) {
        sum = 0u; cnt = 0u; mine = 0u;
#pragma unroll
        for (unsigned j = 0; j < 16; ++j) { const unsigned c = xb_ld(&bar[XB_XCNT(j)]); sum += c; cnt += (c > 0u) ? 1u : 0u; mine = (j == x) ? c : mine; }
        if (sum == G) break;
        __builtin_amdgcn_s_sleep(1);
        if ((++sp & 255u) == 0u) { if (xb_ld(&bar[XB_TMO])) break; if (sp > XB_SPIN_CAP) { atomicAdd(&bar[XB_TMO], 1u); break; } }
    }
    nloc = mine > 0u ? mine : 1u; nx = cnt > 0u ? cnt : 1u;
}
__device__ __forceinline__ void xcd_barrier(const XcdBarrier& b) {
    asm volatile("s_waitcnt vmcnt(0)" ::: "memory");
    __syncthreads();
    if (threadIdx.x == 0) {
        unsigned* bar = b.bar;
        __builtin_amdgcn_s_waitcnt(0);
        unsigned nloc = b.st[0], nx = b.st[1];
        if (nloc == 0u) { xcd_barrier_complete(bar, b.x, nloc, nx); b.st[0] = nloc; b.st[1] = nx; }
        const unsigned old = xb_add(&bar[XB_XSUB(b.x)], 1u);
        const unsigned gen = old / nloc;
        if (old + 1u == (gen + 1u) * nloc) {
            __builtin_amdgcn_fence(__ATOMIC_RELEASE, "agent");
            asm volatile("s_waitcnt vmcnt(0)" ::: "memory");
            const unsigned og = xb_add(&bar[XB_TOP], 1u);
            const unsigned tg = og / nx;
            if (og + 1u == (tg + 1u) * nx) xb_add(&bar[XB_TOPGEN], 1u);
            else XB_SPIN(xb_ld(&bar[XB_TOPGEN]) == tg, bar);
            __builtin_amdgcn_fence(__ATOMIC_ACQUIRE, "agent");
            xb_add(&bar[XB_XGEN(b.x)], 1u);
            asm volatile("s_waitcnt vmcnt(0)" ::: "memory");
        } else {
            XB_SPIN(xb_ld(&bar[XB_XGEN(b.x)]) == gen, bar);
            __builtin_amdgcn_fence(__ATOMIC_ACQUIRE, "agent");
            asm volatile("s_waitcnt vmcnt(0)" ::: "memory");
        }
    }
    __syncthreads();
}

struct Args { const float* in[23]; float* out; unsigned char* ws; int ph_lo, ph_hi; };
enum { I_X = 0, I_C, I_WADA, I_BADA, I_G1, I_W1IN, I_W1OUT, I_GMIX, I_WIN, I_WDW, I_BDW, I_GCLN, I_BCLN, I_WGU, I_BGATE, I_GGLA, I_WOUT, I_G2, I_W2IN, I_W2OUT, I_GFIN, I_WADAF, I_BADAF };

__device__ __forceinline__ void tr_store(bf16* WT, int K, int drow0, int k0, LAS float* scr, int lane) {
    asm volatile("s_waitcnt lgkmcnt(0)" ::: "memory");
    const int c = lane & 7;
#pragma unroll
    for (int j = 0; j < 4; ++j) { const int n = (lane >> 3) + 8 * j; const LAS float* s = scr + (8 * c) * 33 + n;
        v4u o; o.x = pk2(s[0 * 33], s[1 * 33]); o.y = pk2(s[2 * 33], s[3 * 33]); o.z = pk2(s[4 * 33], s[5 * 33]); o.w = pk2(s[6 * 33], s[7 * 33]);
        *(v4u*)(WT + toff(drow0 + n, k0 + 8 * c, K)) = o; }
    asm volatile("s_waitcnt lgkmcnt(0)" ::: "memory");
}
__device__ __forceinline__ void tr_item(const float* W, int K, int N, int n0, int k0, bf16* WT, int drow0, LAS float* scr, int lane) {
    float t[32];
#pragma unroll
    for (int i = 0; i < 32; ++i) t[i] = W[(size_t)(k0 + 2 * i + (lane >> 5)) * N + n0 + (lane & 31)];
#pragma unroll
    for (int i = 0; i < 32; ++i) scr[(2 * i + (lane >> 5)) * 33 + (lane & 31)] = t[i];
    tr_store(WT, K, drow0, k0, scr, lane);
}
__device__ __forceinline__ int pair_row(int n0, int half) { return 256 * (n0 >> 7) + 128 * half + (n0 & 127); }

__device__ __forceinline__ void p0_prologue(const Args& A, LAS unsigned char* lds, int vcu, int G, int tid, int wave, int lane) {
    LAS float* scr = (LAS float*)(lds + wave * 8704);
    LAS float* ca = (LAS float*)(lds + 8 * 8704);
    for (int i = tid; i < 2 * D; i += 512) { const float c = A.in[I_C][i]; ca[i] = c * fsigmoid(c); }
    __syncthreads();
    bf16* WB = (bf16*)(A.ws + WS_W);
    float* PART = (float*)(A.ws + WS_PART);
    const int gw = vcu * 8 + wave, NGW = G * 8;
    constexpr int NGEMV = 320 * 8;
    constexpr int S0 = 16 * 176, S1 = 44 * 32, S2 = 16 * 80, S3 = 16 * 8, S4 = 16 * 32, PER_LAYER = 2 * S0 + 2 * S1 + S2 + S3 + S4;
    constexpr int NITEMS = NGEMV + 2 * PER_LAYER;
    for (int it = gw; it < NITEMS; it += NGW) {
        if (it < NGEMV) {
            const int s = it >> 3, kc = it & 7, k0 = kc * 128;
            const float* W; int N, col0, gcol0;
            if (s < 144) { W = A.in[I_WADA]; N = MODL; col0 = s * 64; gcol0 = col0; }
            else if (s < 288) { W = A.in[I_WADA] + (size_t)D * MODL; N = MODL; col0 = (s - 144) * 64; gcol0 = MODL + col0; }
            else { W = A.in[I_WADAF]; N = 2 * D; col0 = (s - 288) * 64; gcol0 = 2 * MODL + col0; }
            const float* w = W + (size_t)k0 * N + col0 + lane;
            float a0 = 0.f, a1 = 0.f;
#pragma unroll 2
            for (int k1 = 0; k1 < 128; k1 += 32) { float wv[32];
#pragma unroll
                for (int q = 0; q < 32; ++q) wv[q] = w[(size_t)(k1 + q) * N];
#pragma unroll
                for (int q = 0; q < 32; ++q) { a0 += ca[k0 + k1 + q] * wv[q]; a1 += ca[D + k0 + k1 + q] * wv[q]; } }
            PART[((size_t)0 * MODN + gcol0 + lane) * 8 + kc] = a0; PART[((size_t)1 * MODN + gcol0 + lane) * 8 + kc] = a1;
            continue;
        }
        int r = it - NGEMV; const int l = r / PER_LAYER; r -= l * PER_LAYER;
        bf16* WL = WB + (size_t)l * WL_ELEMS;
        if (r < S0) { const int kb = r / 176, nb = r % 176, n0 = nb * 32; const int dr = n0 < DFF ? pair_row(n0, 0) : pair_row(n0 - DFF, 1);
            tr_item(A.in[I_W1IN] + (size_t)l * D * 2 * DFF, D, 2 * DFF, n0, kb * 64, WL + WL_FF1IN, dr, scr, lane); continue; } r -= S0;
        if (r < S1) { const int kb = r / 32, nb = r % 32; tr_item(A.in[I_W1OUT] + (size_t)l * DFF * D, DFF, D, nb * 32, kb * 64, WL + WL_FF1OUT, nb * 32, scr, lane); continue; } r -= S1;
        if (r < S2) { const int kb = r / 80, nb = r % 80, n0 = nb * 32; const int dr = n0 < 512 ? pair_row(n0, 0) : (n0 < 1024 ? pair_row(n0 - 512, 1) : n0);
            tr_item(A.in[I_WIN] + (size_t)l * D * NIN_SRC, D, NIN_SRC, n0, kb * 64, WL + WL_WIN, dr, scr, lane); continue; } r -= S2;
        if (r < S3) {
            const int kb = r / 8, jb = r % 8, k0 = kb * 64, j0 = jb * 32;
            const float* wgu = A.in[I_WGU] + (size_t)l * 16 * 256 + j0 + (lane & 31);
            float wg[16];
#pragma unroll
            for (int q = 0; q < 16; ++q) wg[q] = wgu[q * 256];
            const float* Win = A.in[I_WIN] + (size_t)l * D * NIN_SRC + 2560;
#pragma unroll 4
            for (int i = 0; i < 32; ++i) { const int kk = 2 * i + (lane >> 5); const f32x4* wr = (const f32x4*)(Win + (size_t)(k0 + kk) * NIN_SRC);
                float s = 0.f;
#pragma unroll
                for (int q = 0; q < 4; ++q) { const f32x4 x = wr[q]; s += x[0] * wg[4 * q] + x[1] * wg[4 * q + 1] + x[2] * wg[4 * q + 2] + x[3] * wg[4 * q + 3]; }
                scr[kk * 33 + (lane & 31)] = s; }
            tr_store(WL + WL_WIN, D, 2560 + j0, k0, scr, lane); continue; } r -= S3;
        if (r < S4) { const int kb = r / 32, nb = r % 32; tr_item(A.in[I_WOUT] + (size_t)l * D * D, D, D, nb * 32, kb * 64, WL + WL_WOUT, nb * 32, scr, lane); continue; } r -= S4;
        if (r < S0) { const int kb = r / 176, nb = r % 176, n0 = nb * 32; const int dr = n0 < DFF ? pair_row(n0, 0) : pair_row(n0 - DFF, 1);
            tr_item(A.in[I_W2IN] + (size_t)l * D * 2 * DFF, D, 2 * DFF, n0, kb * 64, WL + WL_FF2IN, dr, scr, lane); continue; } r -= S0;
        { const int kb = r / 32, nb = r % 32; tr_item(A.in[I_W2OUT] + (size_t)l * DFF * D, DFF, D, nb * 32, kb * 64, WL + WL_FF2OUT, nb * 32, scr, lane); }
    }
}
__device__ __forceinline__ float mod_sum(const float* PART, const Args& A, int b, int gc) {
    const f32x4* p = (const f32x4*)(PART + ((size_t)b * MODN + gc) * 8); const f32x4 u = p[0], v = p[1];
    return (((u.x + u.y) + (u.z + u.w)) + ((v.x + v.y) + (v.z + v.w))) + (gc < 2 * MODL ? A.in[I_BADA][gc] : A.in[I_BADAF][gc - 2 * MODL]);
}
__device__ __forceinline__ void p0b_phase(const Args& A, LAS unsigned char* lds, int G, int tid, int wave, int lane, int gw, int NGW) {
    const float* PART = (const float*)(A.ws + WS_PART); float* MOD = (float*)(A.ws + WS_MOD);
    float* GS = (float*)(A.ws + WS_GS); float* CB = (float*)(A.ws + WS_CB); float* SSQ = (float*)(A.ws + WS_SSQ);
    LAS float* shL = (LAS float*)lds;
    LAS float* gsL = shL + 12 * 1024;
    for (int e = blockIdx.x * 512 + tid; e < 2 * MODN; e += G * 512) { const int b = e / MODN, gc = e - b * MODN; MOD[e] = mod_sum(PART, A, b, gc); }
#pragma unroll 8
    for (int e = tid; e < 12 * 1024; e += 512) { const int k = e & 1023, b = (e >> 10) & 1, j = (e >> 11) % 3, l = e / 6144;
        shL[e] = mod_sum(PART, A, b, l * MODL + (3 * j) * D + k); }
    for (int e = tid; e < 2048; e += 512) { const int k = e & 1023, b = e >> 10; gsL[e] = A.in[I_G1][k] * (1.0f + mod_sum(PART, A, b, D + k)); }
    for (int e = blockIdx.x * 512 + tid; e < 12 * 1024; e += G * 512) { const int k = e & 1023, b = (e >> 10) & 1, j = (e >> 11) % 3, l = e / 6144;
        const float* g = (j == 0 ? A.in[I_G1] : j == 1 ? A.in[I_GMIX] : A.in[I_G2]) + l * D;
        GS[e] = g[k] * (1.0f + mod_sum(PART, A, b, l * MODL + (3 * j + 1) * D + k)); }
    __syncthreads();
    const bf16* WB = (const bf16*)(A.ws + WS_W);
    for (int r0 = gw; r0 < 2 * CBROWS; r0 += 4 * NGW) {
        v4u w0[4], w1[4]; int ll[4], rrv[4], jj[4];
#pragma unroll
        for (int q = 0; q < 4; ++q) { const int r = r0 + q * NGW; const bool ok = r < 2 * CBROWS; const int rc = ok ? r : gw;
            const int l = rc / CBROWS, rr = rc - l * CBROWS; const int j = rr < CB_J1 ? 0 : (rr < CB_J2 ? 1 : 2);
            const bf16* wrow = WB + (size_t)l * WL_ELEMS + (j == 0 ? WL_FF1IN + toff(rr, lane * 16, D) : j == 1 ? WL_WIN + toff(rr - CB_J1, lane * 16, D) : WL_FF2IN + toff(rr - CB_J2, lane * 16, D));
            w0[q] = *(const v4u*)(wrow); w1[q] = *(const v4u*)(wrow + 8); ll[q] = l; rrv[q] = ok ? rr : -1; jj[q] = j; }
#pragma unroll
        for (int q = 0; q < 4; ++q) {
            const float wf[16] = {bflo(w0[q].x), bfhi(w0[q].x), bflo(w0[q].y), bfhi(w0[q].y), bflo(w0[q].z), bfhi(w0[q].z), bflo(w0[q].w), bfhi(w0[q].w), bflo(w1[q].x), bfhi(w1[q].x), bflo(w1[q].y), bfhi(w1[q].y), bflo(w1[q].z), bfhi(w1[q].z), bflo(w1[q].w), bfhi(w1[q].w)};
            const LAS float* s0 = shL + ((ll[q] * 3 + jj[q]) * 2 + 0) * 1024 + lane * 16; const LAS float* s1 = s0 + 1024;
            float a0 = 0.f, a1 = 0.f;
#pragma unroll
            for (int e = 0; e < 16; ++e) { a0 += wf[e] * s0[e]; a1 += wf[e] * s1[e]; }
            a0 = wave_sum(a0); a1 = wave_sum(a1);
            if (lane == 0 && rrv[q] >= 0) { CB[(size_t)(ll[q] * 2 + 0) * CBROWS + rrv[q]] = a0; CB[(size_t)(ll[q] * 2 + 1) * CBROWS + rrv[q]] = a1; }
        }
    }
    bf16* H = (bf16*)(A.ws + WS_H);
    for (int m0 = gw; m0 < M; m0 += 4 * NGW) {
        f32x4 v[4][4];
#pragma unroll
        for (int r = 0; r < 4; ++r) { const f32x4* xr = (const f32x4*)(A.in[I_X] + (size_t)(m0 + r * NGW) * D) + lane;
#pragma unroll
            for (int j = 0; j < 4; ++j) v[r][j] = xr[64 * j]; }
#pragma unroll
        for (int r = 0; r < 4; ++r) { const int m = m0 + r * NGW; const LAS f32x4* gl = (const LAS f32x4*)(gsL + (m >> 13) * 1024) + lane; float q = 0.f;
#pragma unroll
            for (int j = 0; j < 4; ++j) { const f32x4 x = v[r][j]; q += (x.x * x.x + x.y * x.y) + (x.z * x.z + x.w * x.w); const f32x4 y = x * gl[64 * j];
                *(unsigned long long*)(H + toff(m, 4 * lane + 256 * j, D)) = (unsigned long long)pk2(y.x, y.y) | ((unsigned long long)pk2(y.z, y.w) << 32); }
            q = wave_sum(q);
            if (lane < 16) SSQ[(size_t)m * 16 + lane] = lane == 0 ? q : 0.f; }
    }
}

__device__ __forceinline__ void normmod_row(const float* xrow, const float* g, const float* shift, const float* scale, bf16* orow, int lane) {
    const f32x4* xr = (const f32x4*)xrow + lane;
    f32x4 v[4]; float s = 0.f;
#pragma unroll
    for (int j = 0; j < 4; ++j) { v[j] = xr[64 * j]; s += (v[j].x * v[j].x + v[j].y * v[j].y) + (v[j].z * v[j].z + v[j].w * v[j].w); }
    const float rstd = 1.0f / sqrtf(wave_sum(s) * (1.0f / D) + EPS);
    unsigned long long* o8 = (unsigned long long*)orow + lane;
#pragma unroll
    for (int j = 0; j < 4; ++j) { const f32x4 gg = ((const f32x4*)g)[lane + 64 * j], sh = ((const f32x4*)shift)[lane + 64 * j], sc = ((const f32x4*)scale)[lane + 64 * j];
        const f32x4 y = (v[j] * rstd * gg) * (sc + 1.0f) + sh;
        o8[64 * j] = (unsigned long long)pk2(y.x, y.y) | ((unsigned long long)pk2(y.z, y.w) << 32); }
}
__device__ __forceinline__ void norm_phase(const float* X, const float* g, const float* MOD, int shift_off, int scale_off, bf16* H, int gw, int NGW, int lane) {
    for (int m = gw; m < M; m += NGW) { const float* mb = MOD + (size_t)(m >> 13) * MODN; normmod_row(X + (size_t)m * D, g, mb + shift_off, mb + scale_off, H + (size_t)m * D, lane); }
}
__device__ __forceinline__ void final_phase(float* X, const float* g, const float* MOD, int gw, int NGW, int lane) {
    for (int m0 = gw; m0 < M; m0 += 4 * NGW) {
        f32x4 v[4][4];
#pragma unroll
        for (int r = 0; r < 4; ++r) { const f32x4* xr = (const f32x4*)(X + (size_t)(m0 + r * NGW) * D) + lane;
#pragma unroll
            for (int j = 0; j < 4; ++j) v[r][j] = xr[64 * j]; }
#pragma unroll
        for (int r = 0; r < 4; ++r) { const int m = m0 + r * NGW; const float* mb = MOD + (size_t)(m >> 13) * MODN + 2 * MODL; f32x4* xr = (f32x4*)(X + (size_t)m * D) + lane; float s = 0.f;
#pragma unroll
            for (int j = 0; j < 4; ++j) s += (v[r][j].x * v[r][j].x + v[r][j].y * v[r][j].y) + (v[r][j].z * v[r][j].z + v[r][j].w * v[r][j].w);
            const float rstd = 1.0f / sqrtf(wave_sum(s) * (1.0f / D) + EPS);
#pragma unroll
            for (int j = 0; j < 4; ++j) { const f32x4 gg = ((const f32x4*)g)[lane + 64 * j], sh = ((const f32x4*)mb)[lane + 64 * j], sc = ((const f32x4*)(mb + D))[lane + 64 * j];
                xr[64 * j] = (v[r][j] * rstd * gg) * (sc + 1.0f) + sh; } }
    }
}

__device__ __forceinline__ void conv_unit(const Args& A, int l, int unit, LAS unsigned char* lds, int tid, int wave, int lane) {
    const int b = unit >> 8, t0 = (unit & 255) * 32;
    LAS unsigned short* uL = (LAS unsigned short*)lds;
    LAS float* yL = (LAS float*)(lds + 63488);
    const bf16* U = (const bf16*)(A.ws + WS_U); bf16* Y = (bf16*)(A.ws + WS_Y);
    for (int r = wave; r < 62; r += 8) { const int t = t0 - 30 + r; v4u v = (v4u){0u, 0u, 0u, 0u};
        if (t >= 0) v = *(const v4u*)(U + ((size_t)(b * SEQ + t)) * DCONV + lane * 8);
        *(LAS v4u*)(uL + r * 512 + lane * 8) = v; }
    __syncthreads();
    {
        const int ch = tid; float w[31];
#pragma unroll
        for (int i = 0; i < 31; ++i) w[i] = A.in[I_WDW][(size_t)(l * CWID + i) * DCONV + ch];
        const float bias = A.in[I_BDW][l * DCONV + ch];
        float acc[32];
#pragma unroll
        for (int r = 0; r < 32; ++r) acc[r] = bias;
#pragma unroll
        for (int i = 0; i < 62; ++i) { const float v = bf2f(uL[i * 512 + ch]);
#pragma unroll
            for (int r = 0; r < 32; ++r) { const int wi = i - r; if (wi >= 0 && wi <= 30) acc[r] += v * w[wi]; } }
#pragma unroll
        for (int r = 0; r < 32; ++r) yL[r * 512 + ch] = acc[r];
    }
    __syncthreads();
    for (int r = wave; r < 32; r += 8) {
        const f32x4 a0 = *(const LAS f32x4*)(yL + r * 512 + lane * 8), a1 = *(const LAS f32x4*)(yL + r * 512 + lane * 8 + 4);
        float v[8] = {a0.x, a0.y, a0.z, a0.w, a1.x, a1.y, a1.z, a1.w}; float s = 0.f;
#pragma unroll
        for (int e = 0; e < 8; ++e) s += v[e];
        const float mean = wave_sum(s) * (1.0f / DCONV); float q = 0.f;
#pragma unroll
        for (int e = 0; e < 8; ++e) { v[e] -= mean; q += v[e] * v[e]; }
        const float rstd = 1.0f / sqrtf(wave_sum(q) * (1.0f / DCONV) + EPS);
        const float* gl = A.in[I_GCLN] + l * DCONV + lane * 8; const float* bl = A.in[I_BCLN] + l * DCONV + lane * 8;
        float o[8];
#pragma unroll
        for (int e = 0; e < 8; ++e) { const float z = v[e] * rstd * gl[e] + bl[e]; o[e] = z * fsigmoid(z); }
        v4u w; w.x = pk2(o[0], o[1]); w.y = pk2(o[2], o[3]); w.z = pk2(o[4], o[5]); w.w = pk2(o[6], o[7]);
        *(v4u*)(Y + toff(b * SEQ + t0 + r, lane * 8, D)) = w;
    }
    __syncthreads();
}

__device__ __forceinline__ void ld_tile_bf16(const bf16* src, int pitch, int ncol, LAS float* dst, int tid) {
    const int per = ncol / 8;
    for (int p = tid; p < 64 * per; p += 512) { const int j = p / per, c = (p % per) * 8; const v4u w = *(const v4u*)(src + (size_t)j * pitch + c);
        LAS float* d = dst + j * ncol + c;
        d[0] = bflo(w.x); d[1] = bfhi(w.x); d[2] = bflo(w.y); d[3] = bfhi(w.y); d[4] = bflo(w.z); d[5] = bfhi(w.z); d[6] = bflo(w.w); d[7] = bfhi(w.w); }
}
__device__ __forceinline__ void gla1_unit(const Args& A, int unit, LAS unsigned char* lds, int tid) {
    const int bh = unit >> 7, n = unit & 127, b = bh >> 2, h = bh & 3; const size_t row0 = (size_t)b * SEQ + (size_t)n * 64;
    LAS float* bcL = (LAS float*)lds; LAS float* kL = bcL + 4096; LAS float* vL = kL + 4096;
    const bf16* QKVR = (const bf16*)(A.ws + WS_QKVR); const float* LAp = (const float*)(A.ws + WS_LA);
    float* UC = (float*)(A.ws + WS_UC); float* GC = (float*)(A.ws + WS_GC);
    for (int p = tid; p < 1024; p += 512) { const int j = p >> 4, c = (p & 15) * 4; *(LAS f32x4*)(bcL + j * 64 + c) = *(const f32x4*)(LAp + (row0 + j) * 256 + h * 64 + c); }
    ld_tile_bf16(QKVR + row0 * 1536 + 256 + h * 64, 1536, 64, kL, tid);
    ld_tile_bf16(QKVR + row0 * 1536 + 512 + h * 128, 1536, 128, vL, tid);
    __syncthreads();
    if (tid < 64) { float s = 0.f;
        for (int j = 0; j < 64; ++j) { s += bcL[j * 64 + tid]; bcL[j * 64 + tid] = s; }
        GC[(size_t)unit * 64 + tid] = __expf(s); }
    __syncthreads();
    for (int e = tid; e < 4096; e += 512) { const int col = e & 63; kL[e] *= __expf(bcL[63 * 64 + col] - bcL[e]); }
    __syncthreads();
    const int kk = tid >> 3, vv0 = (tid & 7) * 16; float a[16];
#pragma unroll
    for (int i = 0; i < 16; ++i) a[i] = 0.f;
    for (int j = 0; j < 64; ++j) { const float kv = kL[j * 64 + kk];
#pragma unroll
        for (int q = 0; q < 4; ++q) { const f32x4 x = *(const LAS f32x4*)(vL + j * 128 + vv0 + 4 * q); a[4 * q] += kv * x.x; a[4 * q + 1] += kv * x.y; a[4 * q + 2] += kv * x.z; a[4 * q + 3] += kv * x.w; } }
    float* up = UC + (size_t)unit * 8192 + kk * 128 + vv0;
#pragma unroll
    for (int q = 0; q < 4; ++q) *(f32x4*)(up + 4 * q) = (f32x4){a[4 * q], a[4 * q + 1], a[4 * q + 2], a[4 * q + 3]};
    __syncthreads();
}
__device__ __forceinline__ void gla2_scan(const Args& A, int G, int tid) {
    const float* UC = (const float*)(A.ws + WS_UC); const float* GC = (const float*)(A.ws + WS_GC); float* SP = (float*)(A.ws + WS_SP);
    for (int e = blockIdx.x * 512 + tid; e < 8 * 8192; e += G * 512) {
        const int bh = e >> 13, kv = e & 8191, kk = kv & 63; float S = 0.f;
        for (int n0 = 0; n0 < NCHUNK; n0 += 8) { float uu[8], gg[8];
#pragma unroll
            for (int q = 0; q < 8; ++q) { const size_t unit = (size_t)bh * 128 + n0 + q; uu[q] = UC[unit * 8192 + kv]; gg[q] = GC[unit * 64 + kk]; }
#pragma unroll
            for (int q = 0; q < 8; ++q) { const size_t unit = (size_t)bh * 128 + n0 + q; SP[unit * 8192 + kv] = S; S = gg[q] * S + uu[q]; } }
    }
}
__device__ __forceinline__ void gla3_unit(const Args& A, int l, int unit, LAS unsigned char* lds, int tid) {
    const int bh = unit >> 7, n = unit & 127, b = bh >> 2, h = bh & 3; const size_t row0 = (size_t)b * SEQ + (size_t)n * 64;
    LAS float* bcL = (LAS float*)lds;
    LAS float* kL = bcL + 4096;
    LAS float* vL = kL + 4096;
    LAS float* attT = vL + 8192;
    LAS float* bcT = attT + 4096;
    LAS float* qT = bcT + 64 * 65;
    const bf16* QKVR = (const bf16*)(A.ws + WS_QKVR); const float* LAp = (const float*)(A.ws + WS_LA);
    const float* SP = (const float*)(A.ws + WS_SP) + (size_t)unit * 8192; bf16* Y = (bf16*)(A.ws + WS_Y);
    for (int p = tid; p < 1024; p += 512) { const int j = p >> 4, c = (p & 15) * 4; *(LAS f32x4*)(bcL + j * 64 + c) = *(const f32x4*)(LAp + (row0 + j) * 256 + h * 64 + c); }
    ld_tile_bf16(QKVR + row0 * 1536 + 256 + h * 64, 1536, 64, kL, tid);
    ld_tile_bf16(QKVR + row0 * 1536 + 512 + h * 128, 1536, 128, vL, tid);
    { const int j = tid >> 3, c = (tid & 7) * 8; const v4u w = *(const v4u*)(QKVR + (row0 + j) * 1536 + h * 64 + c);
      qT[(c + 0) * 65 + j] = bflo(w.x); qT[(c + 1) * 65 + j] = bfhi(w.x); qT[(c + 2) * 65 + j] = bflo(w.y); qT[(c + 3) * 65 + j] = bfhi(w.y);
      qT[(c + 4) * 65 + j] = bflo(w.z); qT[(c + 5) * 65 + j] = bfhi(w.z); qT[(c + 6) * 65 + j] = bflo(w.w); qT[(c + 7) * 65 + j] = bfhi(w.w); }
    __syncthreads();
    if (tid < 64) { float s = 0.f;
        for (int j = 0; j < 64; ++j) { s += bcL[j * 64 + tid]; bcL[j * 64 + tid] = s; bcT[tid * 65 + j] = s; } }
    __syncthreads();
    {
        const int i = tid & 63, jg = tid >> 6; float a[8];
#pragma unroll
        for (int jj = 0; jj < 8; ++jj) a[jj] = 0.f;
        for (int kk = 0; kk < 64; ++kk) { const float qi = qT[kk * 65 + i], bi = bcT[kk * 65 + i];
#pragma unroll
            for (int jj = 0; jj < 8; ++jj) { const int j = jg * 8 + jj; a[jj] += qi * kL[j * 64 + kk] * __expf(-__builtin_fabsf(bi - bcL[j * 64 + kk])); } }
#pragma unroll
        for (int jj = 0; jj < 8; ++jj) attT[(jg * 8 + jj) * 64 + i] = a[jj];
    }
    __syncthreads();
    { const int i = tid & 63, k0 = (tid >> 6) * 8;
#pragma unroll
      for (int c = 0; c < 8; ++c) qT[(k0 + c) * 65 + i] *= __expf(bcT[(k0 + c) * 65 + i]); }
    __syncthreads();
    const int i = tid >> 3, vv0 = (tid & 7) * 16; float o[16];
#pragma unroll
    for (int c = 0; c < 16; ++c) o[c] = 0.f;
    for (int j = 0; j < 64; ++j) { const float av = attT[j * 64 + i];
#pragma unroll
        for (int q = 0; q < 4; ++q) { const f32x4 x = *(const LAS f32x4*)(vL + j * 128 + vv0 + 4 * q); o[4 * q] += av * x.x; o[4 * q + 1] += av * x.y; o[4 * q + 2] += av * x.z; o[4 * q + 3] += av * x.w; } }
    for (int kk = 0; kk < 64; ++kk) { const float qf = qT[kk * 65 + i];
#pragma unroll
        for (int q = 0; q < 4; ++q) { const f32x4 x = *(const f32x4*)(SP + kk * 128 + vv0 + 4 * q); o[4 * q] += qf * x.x; o[4 * q + 1] += qf * x.y; o[4 * q + 2] += qf * x.z; o[4 * q + 3] += qf * x.w; } }
    float ss = 0.f;
#pragma unroll
    for (int c = 0; c < 16; ++c) ss += o[c] * o[c];
    ss += __shfl_xor(ss, 1); ss += __shfl_xor(ss, 2); ss += __shfl_xor(ss, 4);
    const float rstd = 1.0f / sqrtf(ss * (1.0f / DV) + EPS);
    const float* gn = A.in[I_GGLA] + (size_t)l * DGLA + h * DV + vv0;
    const bf16* rp = QKVR + (row0 + i) * 1536 + 1024 + h * DV + vv0;
    const v4u r0 = *(const v4u*)rp, r1 = *(const v4u*)(rp + 8);
    const float rr[16] = {bflo(r0.x), bfhi(r0.x), bflo(r0.y), bfhi(r0.y), bflo(r0.z), bfhi(r0.z), bflo(r0.w), bfhi(r0.w), bflo(r1.x), bfhi(r1.x), bflo(r1.y), bfhi(r1.y), bflo(r1.z), bfhi(r1.z), bflo(r1.w), bfhi(r1.w)};
    float y[16];
#pragma unroll
    for (int c = 0; c < 16; ++c) y[c] = o[c] * rstd * gn[c] * (rr[c] * fsigmoid(rr[c]));
    bf16* yp = Y + (row0 + i) * D + DCONV + h * DV + vv0;
    v4u w0, w1; w0.x = pk2(y[0], y[1]); w0.y = pk2(y[2], y[3]); w0.z = pk2(y[4], y[5]); w0.w = pk2(y[6], y[7]); w1.x = pk2(y[8], y[9]); w1.y = pk2(y[10], y[11]); w1.z = pk2(y[12], y[13]); w1.w = pk2(y[14], y[15]);
    *(v4u*)yp = w0; *(v4u*)(yp + 8) = w1;
    __syncthreads();
}


typedef short bf16x8 __attribute__((ext_vector_type(8)));
typedef float f32x16 __attribute__((ext_vector_type(16)));
constexpr int GP = 72;
constexpr int GPR = 136;
__device__ __forceinline__ bf16x8 ldfrag(const LAS bf16* tile, int rbase, int ks, int lane) { return *(const LAS bf16x8*)(tile + (rbase + (lane & 31)) * GP + 16 * ks + 8 * (lane >> 5)); }
template <int SH> __device__ __forceinline__ int rotc(int r, int c) { return (c + 8 * (r >> SH)) & 63; }
template <int SH> __device__ __forceinline__ bf16x8 ldfrag_rot(const LAS bf16* tile, int rbase, int ks, int lane) { const int r = rbase + (lane & 31); return *(const LAS bf16x8*)(tile + r * GP + rotc<SH>(r, 16 * ks + 8 * (lane >> 5))); }
__device__ __forceinline__ void chunk_cumsum(float (&x)[8], float (&bend)[8], LAS float* tot, int tid, int wave, int lane) {
#pragma unroll
    for (int c = 0; c < 8; ++c) {
        float t = __shfl_up(x[c], 8); if (lane >= 8) x[c] += t;
        t = __shfl_up(x[c], 16); if (lane >= 16) x[c] += t;
        t = __shfl_up(x[c], 32); if (lane >= 32) x[c] += t;
    }
    const int c8 = (tid & 7) * 8;
    if (lane >= 56) {
#pragma unroll
        for (int c = 0; c < 8; ++c) tot[wave * 64 + c8 + c] = x[c];
    }
    __syncthreads();
    float pre[8], all[8];
#pragma unroll
    for (int c = 0; c < 8; ++c) { pre[c] = 0.f; all[c] = 0.f; }
#pragma unroll
    for (int w = 0; w < 8; ++w) { const f32x4 t0 = *(const LAS f32x4*)(tot + w * 64 + c8), t1 = *(const LAS f32x4*)(tot + w * 64 + c8 + 4);
        const float t[8] = {t0.x, t0.y, t0.z, t0.w, t1.x, t1.y, t1.z, t1.w};
#pragma unroll
        for (int c = 0; c < 8; ++c) { all[c] += t[c]; if (w < wave) pre[c] += t[c]; } }
#pragma unroll
    for (int c = 0; c < 8; ++c) { x[c] += pre[c]; bend[c] = all[c]; }
}
__device__ __forceinline__ void unpack8(const v4u w, float (&f)[8]) { f[0] = bflo(w.x); f[1] = bfhi(w.x); f[2] = bflo(w.y); f[3] = bfhi(w.y); f[4] = bflo(w.z); f[5] = bfhi(w.z); f[6] = bflo(w.w); f[7] = bfhi(w.w); }
__device__ __forceinline__ v4u pack8(const float (&f)[8]) { v4u w; w.x = pk2(f[0], f[1]); w.y = pk2(f[2], f[3]); w.z = pk2(f[4], f[5]); w.w = pk2(f[6], f[7]); return w; }

__device__ __forceinline__ void gla1m_unit(const Args& A, int unit, LAS unsigned char* lds, int tid, int wave, int lane) {
    const int bh = unit >> 7, n = unit & 127, b = bh >> 2, h = bh & 3; const size_t row0 = (size_t)b * SEQ + (size_t)n * 64;
    LAS bf16* VT = (LAS bf16*)lds;
    LAS bf16* KDT = VT + 128 * GP;
    LAS float* tot = (LAS float*)(KDT + 64 * GP);
    const bf16* QKVR = (const bf16*)(A.ws + WS_QKVR); const float* LAp = (const float*)(A.ws + WS_LA);
    float* UC = (float*)(A.ws + WS_UC); float* GC = (float*)(A.ws + WS_GC);
    const int row = tid >> 3, c8 = (tid & 7) * 8, v16 = (tid & 7) * 16;
    const float* lap = LAp + (row0 + row) * 256 + h * 64 + c8;
    const f32x4 l0 = *(const f32x4*)lap, l1 = *(const f32x4*)(lap + 4);
    const bf16* rp = QKVR + (row0 + row) * 1536;
    const v4u kw = *(const v4u*)(rp + 256 + h * 64 + c8);
    const v4u vw0 = *(const v4u*)(rp + 512 + h * 128 + v16), vw1 = *(const v4u*)(rp + 512 + h * 128 + v16 + 8);
    float bc[8] = {l0.x, l0.y, l0.z, l0.w, l1.x, l1.y, l1.z, l1.w}, bend[8];
    chunk_cumsum(bc, bend, tot, tid, wave, lane);
    float kf[8]; unpack8(kw, kf);
#pragma unroll
    for (int c = 0; c < 8; ++c) KDT[(c8 + c) * GP + row] = (bf16)f2bf(kf[c] * __expf(bend[c] - bc[c]));
    { const unsigned vv[8] = {vw0.x, vw0.y, vw0.z, vw0.w, vw1.x, vw1.y, vw1.z, vw1.w};
#pragma unroll
      for (int c = 0; c < 8; ++c) { VT[(v16 + 2 * c) * GP + row] = (bf16)(vv[c] & 0xffffu); VT[(v16 + 2 * c + 1) * GP + row] = (bf16)(vv[c] >> 16); } }
    if (row == 63) {
#pragma unroll
        for (int c = 0; c < 8; ++c) GC[(size_t)unit * 64 + c8 + c] = __expf(bend[c]);
    }
    __syncthreads();
    const int mt = wave & 3, kb = wave >> 2;
    f32x16 acc;
#pragma unroll
    for (int r = 0; r < 16; ++r) acc[r] = 0.f;
#pragma unroll
    for (int ks = 0; ks < 4; ++ks) acc = __builtin_amdgcn_mfma_f32_32x32x16_bf16(ldfrag(VT, 32 * mt, ks, lane), ldfrag(KDT, 32 * kb, ks, lane), acc, 0, 0, 0);
    float* up = UC + (size_t)unit * 8192 + 32 * kb + (lane & 31);
#pragma unroll
    for (int r = 0; r < 16; ++r) { const int vc = 32 * mt + (r & 3) + 8 * (r >> 2) + 4 * (lane >> 5); up[vc * 64] = acc[r]; }
    __syncthreads();
}
__device__ __forceinline__ void gla3m_unit(const Args& A, int l, int unit, LAS unsigned char* lds, int tid, int wave, int lane) {
    const int bh = unit >> 7, n = unit & 127, b = bh >> 2, h = bh & 3; const size_t row0 = (size_t)b * SEQ + (size_t)n * 64;
    LAS bf16* QF = (LAS bf16*)lds;
    LAS bf16* QB = QF + 64 * GP;
    LAS bf16* KF = QB + 64 * GP;
    LAS bf16* KB = KF + 64 * GP;
    LAS bf16* ATT = KB + 64 * GP;
    LAS bf16* VT = ATT + 64 * GP;
    LAS bf16* ST = VT + 128 * GP;
    LAS bf16* RT = ST + 128 * GP;
    LAS float* tot = (LAS float*)(RT + 64 * GPR);
    LAS float* ssL = tot + 512;
    const bf16* QKVR = (const bf16*)(A.ws + WS_QKVR); const float* LAp = (const float*)(A.ws + WS_LA);
    const float* SP = (const float*)(A.ws + WS_SP) + (size_t)unit * 8192; bf16* Y = (bf16*)(A.ws + WS_Y);
    const int row = tid >> 3, c8 = (tid & 7) * 8, v16 = (tid & 7) * 16;
    const float* lap = LAp + (row0 + row) * 256 + h * 64 + c8;
    const f32x4 l0 = *(const f32x4*)lap, l1 = *(const f32x4*)(lap + 4);
    const bf16* rp = QKVR + (row0 + row) * 1536;
    const v4u qw = *(const v4u*)(rp + h * 64 + c8), kw = *(const v4u*)(rp + 256 + h * 64 + c8);
    const v4u vw0 = *(const v4u*)(rp + 512 + h * 128 + v16), vw1 = *(const v4u*)(rp + 512 + h * 128 + v16 + 8);
    const v4u rw0 = *(const v4u*)(rp + 1024 + h * 128 + v16), rw1 = *(const v4u*)(rp + 1024 + h * 128 + v16 + 8);
    { const int vc = tid >> 2, k0 = (tid & 3) * 16; const float* sp = SP + vc * 64 + k0;
      const f32x4 s0 = *(const f32x4*)sp, s1 = *(const f32x4*)(sp + 4), s2 = *(const f32x4*)(sp + 8), s3 = *(const f32x4*)(sp + 12);
      v4u w0, w1; w0.x = pk2(s0.x, s0.y); w0.y = pk2(s0.z, s0.w); w0.z = pk2(s1.x, s1.y); w0.w = pk2(s1.z, s1.w); w1.x = pk2(s2.x, s2.y); w1.y = pk2(s2.z, s2.w); w1.z = pk2(s3.x, s3.y); w1.w = pk2(s3.z, s3.w);
      *(LAS v4u*)(ST + vc * GP + k0) = w0; *(LAS v4u*)(ST + vc * GP + k0 + 8) = w1; }
    float bc[8] = {l0.x, l0.y, l0.z, l0.w, l1.x, l1.y, l1.z, l1.w}, bend[8];
    chunk_cumsum(bc, bend, tot, tid, wave, lane);
    {
        float qf[8], kf[8], a[8], c_[8], d_[8], e_[8]; unpack8(qw, qf); unpack8(kw, kf);
#pragma unroll
        for (int c = 0; c < 8; ++c) { const float e = __expf(bc[c]), ei = __expf(-bc[c]); a[c] = qf[c] * e; c_[c] = qf[c] * ei; d_[c] = kf[c] * e; e_[c] = kf[c] * ei; }
        *(LAS v4u*)(QF + row * GP + c8) = pack8(a); *(LAS v4u*)(QB + row * GP + c8) = pack8(c_); *(LAS v4u*)(KF + row * GP + c8) = pack8(d_); *(LAS v4u*)(KB + row * GP + c8) = pack8(e_);
    }
    { const unsigned vv[8] = {vw0.x, vw0.y, vw0.z, vw0.w, vw1.x, vw1.y, vw1.z, vw1.w};
#pragma unroll
      for (int c = 0; c < 8; ++c) { VT[(v16 + 2 * c) * GP + row] = (bf16)(vv[c] & 0xffffu); VT[(v16 + 2 * c + 1) * GP + row] = (bf16)(vv[c] >> 16); } }
    *(LAS v4u*)(RT + row * GPR + v16) = rw0; *(LAS v4u*)(RT + row * GPR + v16 + 8) = rw1;
    __syncthreads();
    if (wave < 4) {
        const int ib = wave >> 1, jb = wave & 1;
        f32x16 p1, p2;
#pragma unroll
        for (int r = 0; r < 16; ++r) { p1[r] = 0.f; p2[r] = 0.f; }
        if (ib >= jb) {
#pragma unroll
            for (int ks = 0; ks < 4; ++ks) p1 = __builtin_amdgcn_mfma_f32_32x32x16_bf16(ldfrag(KB, 32 * jb, ks, lane), ldfrag(QF, 32 * ib, ks, lane), p1, 0, 0, 0);
        }
        if (ib <= jb) {
#pragma unroll
            for (int ks = 0; ks < 4; ++ks) p2 = __builtin_amdgcn_mfma_f32_32x32x16_bf16(ldfrag(KF, 32 * jb, ks, lane), ldfrag(QB, 32 * ib, ks, lane), p2, 0, 0, 0);
        }
        const int i = 32 * ib + (lane & 31);
#pragma unroll
        for (int g = 0; g < 4; ++g) { const int j0 = 32 * jb + 8 * g + 4 * (lane >> 5); float v[4];
#pragma unroll
            for (int e = 0; e < 4; ++e) v[e] = (i >= j0 + e) ? p1[4 * g + e] : p2[4 * g + e];
            v2u w; w.x = pk2(v[0], v[1]); w.y = pk2(v[2], v[3]); *(LAS v2u*)(ATT + i * GP + j0) = w; }
    }
    __syncthreads();
    const int mt = wave & 3, nt = wave >> 2, i = 32 * nt + (lane & 31), hh = lane >> 5;
    f32x16 acc;
#pragma unroll
    for (int r = 0; r < 16; ++r) acc[r] = 0.f;
#pragma unroll
    for (int ks = 0; ks < 4; ++ks) acc = __builtin_amdgcn_mfma_f32_32x32x16_bf16(ldfrag(VT, 32 * mt, ks, lane), ldfrag(ATT, 32 * nt, ks, lane), acc, 0, 0, 0);
#pragma unroll
    for (int ks = 0; ks < 4; ++ks) acc = __builtin_amdgcn_mfma_f32_32x32x16_bf16(ldfrag(ST, 32 * mt, ks, lane), ldfrag(QF, 32 * nt, ks, lane), acc, 0, 0, 0);
    float ss = 0.f;
#pragma unroll
    for (int r = 0; r < 16; ++r) ss += acc[r] * acc[r];
    ss += __shfl_xor(ss, 32);
    if (hh == 0) ssL[mt * 64 + i] = ss;
    __syncthreads();
    const float rstd = 1.0f / sqrtf((ssL[i] + ssL[64 + i] + ssL[128 + i] + ssL[192 + i]) * (1.0f / DV) + EPS);
    const float* gn = A.in[I_GGLA] + (size_t)l * DGLA + h * DV;
#pragma unroll
    for (int g = 0; g < 4; ++g) { const int vc0 = 32 * mt + 8 * g + 4 * hh; const f32x4 gv = *(const f32x4*)(gn + vc0);
        const v2u rw = *(const LAS v2u*)(RT + i * GPR + vc0); const float r0 = bflo(rw.x), r1 = bfhi(rw.x), r2 = bflo(rw.y), r3 = bfhi(rw.y);
        const float y0 = acc[4 * g] * rstd * gv.x * (r0 * fsigmoid(r0)), y1 = acc[4 * g + 1] * rstd * gv.y * (r1 * fsigmoid(r1)), y2 = acc[4 * g + 2] * rstd * gv.z * (r2 * fsigmoid(r2)), y3 = acc[4 * g + 3] * rstd * gv.w * (r3 * fsigmoid(r3));
        v2u w; w.x = pk2(y0, y1); w.y = pk2(y2, y3); *(LAS v2u*)(RT + i * GPR + vc0) = w; }
    __syncthreads();
    { bf16* yp = Y + toff((int)row0 + row, DCONV + h * DV + v16, D); *(v4u*)yp = *(const LAS v4u*)(RT + row * GPR + v16); *(v4u*)(yp + 8) = *(const LAS v4u*)(RT + row * GPR + v16 + 8); }
    __syncthreads();
}


__device__ __forceinline__ void chunk_cumsum2(float (&x)[8], float (&bend)[8], LAS float* tile, LAS float* tot, int tid, int wave, int lane) {
    const int row = tid >> 3, c8 = (tid & 7) * 8;
    *(LAS f32x4*)(tile + row * 64 + c8) = (f32x4){x[0], x[1], x[2], x[3]}; *(LAS f32x4*)(tile + row * 64 + c8 + 4) = (f32x4){x[4], x[5], x[6], x[7]};
    __syncthreads();
    { LAS float* p = tile + (wave * 8) * 64 + lane; float v[8];
#pragma unroll
      for (int i = 0; i < 8; ++i) v[i] = p[i * 64];
#pragma unroll
      for (int i = 1; i < 8; ++i) v[i] += v[i - 1];
#pragma unroll
      for (int i = 0; i < 8; ++i) p[i * 64] = v[i];
      tot[wave * 64 + lane] = v[7]; }
    __syncthreads();
    const f32x4 a0 = *(const LAS f32x4*)(tile + row * 64 + c8), a1 = *(const LAS f32x4*)(tile + row * 64 + c8 + 4);
    float pre[8], all[8];
#pragma unroll
    for (int c = 0; c < 8; ++c) { pre[c] = 0.f; all[c] = 0.f; }
#pragma unroll
    for (int w = 0; w < 8; ++w) { const f32x4 t0 = *(const LAS f32x4*)(tot + w * 64 + c8), t1 = *(const LAS f32x4*)(tot + w * 64 + c8 + 4);
        const float t[8] = {t0.x, t0.y, t0.z, t0.w, t1.x, t1.y, t1.z, t1.w};
#pragma unroll
        for (int c = 0; c < 8; ++c) { all[c] += t[c]; if (w < wave) pre[c] += t[c]; } }
    const float loc[8] = {a0.x, a0.y, a0.z, a0.w, a1.x, a1.y, a1.z, a1.w};
#pragma unroll
    for (int c = 0; c < 8; ++c) { x[c] = loc[c] + pre[c]; bend[c] = all[c]; }
}
template <int SA, int SB> __device__ __forceinline__ f32x16 mma_k64(const LAS bf16* TA, int ra, const LAS bf16* TB, int rb, f32x16 acc, int lane) {
    bf16x8 a[4], b[4];
#pragma unroll
    for (int ks = 0; ks < 4; ++ks) { if constexpr (SA < 0) a[ks] = ldfrag(TA, ra, ks, lane); else a[ks] = ldfrag_rot<SA>(TA, ra, ks, lane);
                                     if constexpr (SB < 0) b[ks] = ldfrag(TB, rb, ks, lane); else b[ks] = ldfrag_rot<SB>(TB, rb, ks, lane); }
#pragma unroll
    for (int ks = 0; ks < 4; ++ks) acc = __builtin_amdgcn_mfma_f32_32x32x16_bf16(a[ks], b[ks], acc, 0, 0, 0);
    return acc;
}
#define GLA_LOAD1(c_) do { const size_t r_ = rowg + (size_t)(c_) * 64 + row; const float* lap_ = LAp + r_ * 256 + h * 64 + c8; l0 = *(const f32x4*)lap_; l1 = *(const f32x4*)(lap_ + 4); \
        const bf16* rp_ = QKVR + r_ * 1536; kw = *(const v4u*)(rp_ + 256 + h * 64 + c8); vw0 = *(const v4u*)(rp_ + 512 + h * 128 + v16); vw1 = *(const v4u*)(rp_ + 512 + h * 128 + v16 + 8); } while (0)
__device__ __forceinline__ void gla_p1_unit(const Args& A, int unit, LAS unsigned char* lds, int tid, int wave, int lane) {
    const int bh = unit >> 5, grp = unit & 31, b = bh >> 2, h = bh & 3; const size_t rowg = (size_t)b * SEQ + (size_t)grp * 256;
    LAS bf16* VT = (LAS bf16*)lds;
    LAS bf16* KDT = VT + 128 * GP;
    LAS float* tot = (LAS float*)(KDT + 64 * GP);
    LAS float* gL = tot + 512;
    LAS float* cst = gL + 64;
    const bf16* QKVR = (const bf16*)(A.ws + WS_QKVR); const float* LAp = (const float*)(A.ws + WS_LA);
    float* UG = (float*)(A.ws + WS_UC); float* GG = (float*)(A.ws + WS_GC);
    const int row = tid >> 3, c8 = (tid & 7) * 8, v16 = (tid & 7) * 16;
    const int mt = wave & 3, kb = wave >> 2;
    f32x16 acc;
#pragma unroll
    for (int r = 0; r < 16; ++r) acc[r] = 0.f;
    float gprod[8];
#pragma unroll
    for (int c = 0; c < 8; ++c) gprod[c] = 1.f;
    f32x4 l0, l1; v4u kw, vw0, vw1;
    GLA_LOAD1(0);
#pragma unroll
    for (int ch = 0; ch < 4; ++ch) {
        float bc[8] = {l0.x, l0.y, l0.z, l0.w, l1.x, l1.y, l1.z, l1.w}, bend[8]; const v4u kwc = kw, v0c = vw0, v1c = vw1;
        if (ch < 3) GLA_LOAD1(ch + 1);
        chunk_cumsum2(bc, bend, cst, tot, tid, wave, lane);
        float kf[8]; unpack8(kwc, kf);
#pragma unroll
        for (int c = 0; c < 8; ++c) KDT[(c8 + c) * GP + rotc<3>(c8 + c, row)] = (bf16)f2bf(kf[c] * __expf(bend[c] - bc[c]));
        { const unsigned vv[8] = {v0c.x, v0c.y, v0c.z, v0c.w, v1c.x, v1c.y, v1c.z, v1c.w};
#pragma unroll
          for (int c = 0; c < 8; ++c) { VT[(v16 + 2 * c) * GP + rotc<4>(v16 + 2 * c, row)] = (bf16)(vv[c] & 0xffffu); VT[(v16 + 2 * c + 1) * GP + rotc<4>(v16 + 2 * c + 1, row)] = (bf16)(vv[c] >> 16); } }
        if (row == 63) {
#pragma unroll
            for (int c = 0; c < 8; ++c) { const float g = __expf(bend[c]); gL[c8 + c] = g; gprod[c] *= g; }
        }
        __syncthreads();
        const float gk = gL[32 * kb + (lane & 31)];
#pragma unroll
        for (int r = 0; r < 16; ++r) acc[r] *= gk;
        acc = mma_k64<4, 3>(VT, 32 * mt, KDT, 32 * kb, acc, lane);
    }
    float* up = UG + (size_t)unit * 8192 + 32 * kb + (lane & 31);
#pragma unroll
    for (int r = 0; r < 16; ++r) { const int vc = 32 * mt + (r & 3) + 8 * (r >> 2) + 4 * (lane >> 5); up[vc * 64] = acc[r]; }
    if (row == 63) {
#pragma unroll
        for (int c = 0; c < 8; ++c) GG[(size_t)unit * 64 + c8 + c] = gprod[c];
    }
    __syncthreads();
}
__device__ __forceinline__ void gla_scan2(const Args& A, int G, int tid) {
    const float* UG = (const float*)(A.ws + WS_UC); const float* GG = (const float*)(A.ws + WS_GC); float* SS = (float*)(A.ws + WS_SP);
    const int gthreads = G * 256;
    for (int e = blockIdx.x * 256 + (tid & 255); e < 8 * 8192; e += gthreads) {
        if (tid >= 256) continue;
        const int bh = e >> 13, kv = e & 8191, kk = kv & 63; float S = 0.f;
        float uu[32], gg[32];
#pragma unroll
        for (int q = 0; q < 32; ++q) { const size_t unit = (size_t)bh * 32 + q; uu[q] = UG[unit * 8192 + kv]; gg[q] = GG[unit * 64 + kk]; }
#pragma unroll
        for (int q = 0; q < 32; ++q) { const size_t unit = (size_t)bh * 32 + q; SS[unit * 8192 + kv] = S; S = gg[q] * S + uu[q]; }
    }
}
#define GLA_LOAD2(c_) do { const size_t r_ = rowg + (size_t)(c_) * 64 + row; const float* lap_ = LAp + r_ * 256 + h * 64 + c8; l0 = *(const f32x4*)lap_; l1 = *(const f32x4*)(lap_ + 4); \
        const bf16* rp_ = QKVR + r_ * 1536; qw = *(const v4u*)(rp_ + h * 64 + c8); kw = *(const v4u*)(rp_ + 256 + h * 64 + c8); \
        vw0 = *(const v4u*)(rp_ + 512 + h * 128 + v16); vw1 = *(const v4u*)(rp_ + 512 + h * 128 + v16 + 8); rw0 = *(const v4u*)(rp_ + 1024 + h * 128 + v16); rw1 = *(const v4u*)(rp_ + 1024 + h * 128 + v16 + 8); } while (0)
__device__ __forceinline__ void gla_p2_unit(const Args& A, int l, int unit, LAS unsigned char* lds, int tid, int wave, int lane) {
    const int bh = unit >> 5, grp = unit & 31, b = bh >> 2, h = bh & 3; const size_t rowg = (size_t)b * SEQ + (size_t)grp * 256;
    LAS bf16* QF = (LAS bf16*)lds;
    LAS bf16* QB = QF + 64 * GP;
    LAS bf16* KF = QB + 64 * GP;
    LAS bf16* KB = KF + 64 * GP;
    LAS bf16* ATT = KB + 64 * GP;
    LAS bf16* KDT = ATT + 64 * GP;
    LAS bf16* VT = KDT + 64 * GP;
    LAS bf16* ST = VT + 128 * GP;
    LAS bf16* RT = ST + 128 * GP;
    LAS float* tot = (LAS float*)(RT + 64 * GPR);
    LAS float* ssL = tot + 512;
    LAS float* gL = ssL + 256;
    LAS float* cst = gL + 64;
    const bf16* QKVR = (const bf16*)(A.ws + WS_QKVR); const float* LAp = (const float*)(A.ws + WS_LA);
    const float* SS = (const float*)(A.ws + WS_SP) + (size_t)unit * 8192; bf16* Y = (bf16*)(A.ws + WS_Y);
    const int row = tid >> 3, c8 = (tid & 7) * 8, v16 = (tid & 7) * 16;
    const int vb = wave & 3, kb = wave >> 2, hh = lane >> 5;
    const int mt = wave & 3, nt = wave >> 2, i = 32 * nt + (lane & 31);
    f32x16 X;
    { const float* sp = SS + (size_t)(32 * vb + (lane & 31)) * 64 + 32 * kb + 4 * hh;
#pragma unroll
      for (int g = 0; g < 4; ++g) { const f32x4 t = *(const f32x4*)(sp + 8 * g); X[4 * g] = t.x; X[4 * g + 1] = t.y; X[4 * g + 2] = t.z; X[4 * g + 3] = t.w; } }
    f32x4 l0, l1; v4u qw, kw, vw0, vw1, rw0, rw1;
    GLA_LOAD2(0);
    const float* gn = A.in[I_GGLA] + (size_t)l * DGLA + h * DV;
    f32x4 gnv[4];
#pragma unroll
    for (int g = 0; g < 4; ++g) gnv[g] = *(const f32x4*)(gn + 32 * mt + 8 * g + 4 * hh);
#pragma unroll 1
    for (int ch = 0; ch < 4; ++ch) {
        float bc[8] = {l0.x, l0.y, l0.z, l0.w, l1.x, l1.y, l1.z, l1.w}, bend[8];
        const v4u qwc = qw, kwc = kw, v0c = vw0, v1c = vw1, r0c = rw0, r1c = rw1;
        if (ch < 3) GLA_LOAD2(ch + 1);
        chunk_cumsum2(bc, bend, cst, tot, tid, wave, lane);
        {
            float qf[8], kf[8], a[8], c_[8], d_[8], e_[8]; unpack8(qwc, qf); unpack8(kwc, kf);
#pragma unroll
            for (int c = 0; c < 8; ++c) { const float e = __expf(bc[c]), ei = __expf(-bc[c]); a[c] = qf[c] * e; c_[c] = qf[c] * ei; d_[c] = kf[c] * e; e_[c] = kf[c] * ei;
                KDT[(c8 + c) * GP + rotc<3>(c8 + c, row)] = (bf16)f2bf(kf[c] * __expf(bend[c] - bc[c])); }
            *(LAS v4u*)(QF + row * GP + c8) = pack8(a); *(LAS v4u*)(QB + row * GP + c8) = pack8(c_); *(LAS v4u*)(KF + row * GP + c8) = pack8(d_); *(LAS v4u*)(KB + row * GP + c8) = pack8(e_);
        }
        { const unsigned vv[8] = {v0c.x, v0c.y, v0c.z, v0c.w, v1c.x, v1c.y, v1c.z, v1c.w};
#pragma unroll
          for (int c = 0; c < 8; ++c) { VT[(v16 + 2 * c) * GP + rotc<4>(v16 + 2 * c, row)] = (bf16)(vv[c] & 0xffffu); VT[(v16 + 2 * c + 1) * GP + rotc<4>(v16 + 2 * c + 1, row)] = (bf16)(vv[c] >> 16); } }
        *(LAS v4u*)(RT + row * GPR + v16) = r0c; *(LAS v4u*)(RT + row * GPR + v16 + 8) = r1c;
        if (row == 63) {
#pragma unroll
            for (int c = 0; c < 8; ++c) gL[c8 + c] = __expf(bend[c]);
        }
        {
            LAS bf16* sp = ST + (32 * vb + (lane & 31)) * GP + 32 * kb + 4 * hh;
#pragma unroll
            for (int g = 0; g < 4; ++g) { v2u w; w.x = pk2(X[4 * g], X[4 * g + 1]); w.y = pk2(X[4 * g + 2], X[4 * g + 3]); *(LAS v2u*)(sp + 8 * g) = w; }
        }
        __syncthreads();
        if (wave < 4) {
            const int ib = wave >> 1, jb = wave & 1;
            f32x16 p1, p2;
#pragma unroll
            for (int r = 0; r < 16; ++r) { p1[r] = 0.f; p2[r] = 0.f; }
            if (ib >= jb) {
                p1 = mma_k64<-1, -1>(KB, 32 * jb, QF, 32 * ib, p1, lane);
            }
            if (ib <= jb) {
                p2 = mma_k64<-1, -1>(KF, 32 * jb, QB, 32 * ib, p2, lane);
            }
            const int ia = 32 * ib + (lane & 31);
#pragma unroll
            for (int g = 0; g < 4; ++g) { const int j0 = 32 * jb + 8 * g + 4 * hh; float v[4];
#pragma unroll
                for (int e = 0; e < 4; ++e) v[e] = (ia >= j0 + e) ? p1[4 * g + e] : p2[4 * g + e];
                v2u w; w.x = pk2(v[0], v[1]); w.y = pk2(v[2], v[3]); *(LAS v2u*)(ATT + ia * GP + j0) = w; }
        }
        {
#pragma unroll
            for (int g = 0; g < 4; ++g) { const f32x4 gq = *(const LAS f32x4*)(gL + 32 * kb + 8 * g + 4 * hh); X[4 * g] *= gq.x; X[4 * g + 1] *= gq.y; X[4 * g + 2] *= gq.z; X[4 * g + 3] *= gq.w; }
            X = mma_k64<3, 4>(KDT, 32 * kb, VT, 32 * vb, X, lane);
        }
        __syncthreads();
        f32x16 acc;
#pragma unroll
        for (int r = 0; r < 16; ++r) acc[r] = 0.f;
        acc = mma_k64<4, -1>(VT, 32 * mt, ATT, 32 * nt, acc, lane);
        acc = mma_k64<-1, -1>(ST, 32 * mt, QF, 32 * nt, acc, lane);
        float ss = 0.f;
#pragma unroll
        for (int r = 0; r < 16; ++r) ss += acc[r] * acc[r];
        ss += __shfl_xor(ss, 32);
        if (hh == 0) ssL[mt * 64 + i] = ss;
        __syncthreads();
        const float rstd = 1.0f / sqrtf((ssL[i] + ssL[64 + i] + ssL[128 + i] + ssL[192 + i]) * (1.0f / DV) + EPS);
#pragma unroll
        for (int g = 0; g < 4; ++g) { const int vc0 = 32 * mt + 8 * g + 4 * hh; const f32x4 gv = gnv[g];
            const v2u rw = *(const LAS v2u*)(RT + i * GPR + vc0); const float r0 = bflo(rw.x), r1 = bfhi(rw.x), r2 = bflo(rw.y), r3 = bfhi(rw.y);
            const float y0 = acc[4 * g] * rstd * gv.x * (r0 * fsigmoid(r0)), y1 = acc[4 * g + 1] * rstd * gv.y * (r1 * fsigmoid(r1)), y2 = acc[4 * g + 2] * rstd * gv.z * (r2 * fsigmoid(r2)), y3 = acc[4 * g + 3] * rstd * gv.w * (r3 * fsigmoid(r3));
            v2u w; w.x = pk2(y0, y1); w.y = pk2(y2, y3); *(LAS v2u*)(RT + i * GPR + vc0) = w; }
        __syncthreads();
        { bf16* yp = Y + toff((int)(rowg + (size_t)ch * 64) + row, DCONV + h * DV + v16, D); *(v4u*)yp = *(const LAS v4u*)(RT + row * GPR + v16); *(v4u*)(yp + 8) = *(const LAS v4u*)(RT + row * GPR + v16 + 8); }
    }
    __syncthreads();
}

constexpr int NPHASES = 2 + 2 * 9 + 1 + (PROBE_KIND == 1 ? 20 : PROBE_KIND == 2 ? 1 : PROBE_KIND == 3 ? 4 : PROBE_KIND == 4 ? 2 : PROBE_KIND == 5 ? 6 : PROBE_KIND == 7 ? 4 : PROBE_KIND == 8 ? 2 : PROBE_KIND == 9 ? 1 : (PROBE_KIND == 10 || PROBE_KIND == 11) ? 4 : (PROBE_KIND >= 12 && PROBE_KIND <= 15) ? 2 : 0);
__global__ void __launch_bounds__(512, 2) fwd_kernel(Args args) {
    extern __shared__ __attribute__((aligned(16))) unsigned char lds_raw[];
    LAS unsigned char* lds = (LAS unsigned char*)lds_raw;
    volatile LAS unsigned* MISC = (volatile LAS unsigned*)(lds + MISC_OFF);
    const int G = gridDim.x; const int bx = blockIdx.x; const int vcu = (G % 8 == 0) ? (bx % 8) * (G / 8) + bx / 8 : bx;
    const int NGW = G * 8;
    unsigned char* ws = args.ws;
    for (int u = threadIdx.x; u < (LDS_BYTES - RING_BYTES) / 4; u += 512) ((LAS unsigned*)(lds + RING_BYTES))[u] = 0u;
    __syncthreads();
    XcdBarrier bar; bar.bar = (unsigned*)(ws + WS_CTL) + CW_BAR; bar.x = 0; bar.st = nullptr;
    if (N_LAUNCH_MODE == 0) bar = xcd_barrier_post((unsigned*)(ws + WS_CTL) + CW_BAR, MISC + 8);
    const int lo = args.ph_lo, hi = args.ph_hi;
    int ph = 0;
#define PH_BEGIN if (lo <= ph && ph < hi) { int tid = threadIdx.x; asm volatile("" : "+v"(tid)); const int lane = tid & 63, wave = __builtin_amdgcn_readfirstlane(tid >> 6), gw = vcu * 8 + wave; (void)lane; (void)gw;
#define PH_END   if (N_LAUNCH_MODE == 0 && ph + 1 < hi) xcd_barrier(bar); } ++ph;

    float* X = args.out;
    const float* MOD = (const float*)(ws + WS_MOD);
    bf16* H = (bf16*)(ws + WS_H); bf16* ACT = (bf16*)(ws + WS_ACT); bf16* Y = (bf16*)(ws + WS_Y);

    for (int rep = 0; rep < (PROBE_KIND == 2 ? 2 : 1); ++rep) { PH_BEGIN p0_prologue(args, lds, vcu, G, tid, wave, lane); PH_END }
    if (PROBE_KIND == 1) for (int rep = 0; rep < 20; ++rep) { PH_BEGIN PH_END }
    for (int rep = 0; rep < (PROBE_KIND == 9 ? 2 : 1); ++rep) { PH_BEGIN p0b_phase(args, lds, G, tid, wave, lane, gw, NGW); PH_END }

    const float* SSQ = (const float*)(ws + WS_SSQ); const float* GS = (const float*)(ws + WS_GS); const float* CB = (const float*)(ws + WS_CB);
#pragma nounroll
    for (int l = 0; l < 2; ++l) {
        const bf16* WL = (const bf16*)(ws + WS_W) + (size_t)l * WL_ELEMS;
#pragma nounroll
        for (int f = 0; f < 2; ++f) {
            const float* xin = (l == 0 && f == 0) ? args.in[I_X] : X;
            const int mo = l * MODL + (f == 0 ? 0 : 6) * D;
            for (int rep = 0; rep < (PROBE_KIND == 3 ? 2 : 1); ++rep) {
            PH_BEGIN { pg8::Gemm g{H, WL + (f == 0 ? WL_FF1IN : WL_FF2IN), M, 2 * DFF, D}; pg8::StaticOrder S; S.init(M, 2 * DFF, G, bx);
                pg8::EpiSwiGLU E{ACT, SSQ, CB + (size_t)(l * 2) * CBROWS + (f == 0 ? CB_J0 : CB_J2), DFF, 0}; pg8::gemm_phase<pg8::EpiSwiGLU, pg8::StaticOrder, true, true>(lds, g, S, E); } PH_END }
            if (PROBE_KIND == 10) { PH_BEGIN { pg8::Gemm g{ACT, WL + (f == 0 ? WL_FF1OUT : WL_FF2OUT), M, D, DFF}; pg8::StaticOrder S; S.init(M, D, G, bx);
                pg8::EpiNull E{0}; pg8::gemm_phase<pg8::EpiNull, pg8::StaticOrder, true, true>(lds, g, S, E); } PH_END }
            if (PROBE_KIND == 11) { PH_BEGIN { pg8::Gemm g{H, WL + (f == 0 ? WL_FF1IN : WL_FF2IN), M, 2 * DFF, D}; pg8::StaticOrder S; S.init(M, 2 * DFF, G, bx);
                pg8::EpiNull E{0}; pg8::gemm_phase<pg8::EpiNull, pg8::StaticOrder, true, true>(lds, g, S, E); } PH_END }
            for (int rep = (PROBE_KIND == 7 ? 0 : 1); rep < 2; ++rep) {
            PH_BEGIN { pg8::Gemm g{ACT, WL + (f == 0 ? WL_FF1OUT : WL_FF2OUT), M, D, DFF}; pg8::StaticOrder S; S.init(M, D, G, bx);
                const int jn = (f == 0) ? l * 3 + 1 : (l == 0 ? 3 : 0);
                pg8::EpiResid E{xin, rep == 0 ? (float*)(ws + WS_Y) : X, MOD + mo + 2 * D, H, GS + (size_t)(jn * 2) * D, (float*)(ws + WS_SSQ), D, 0.5f};
                pg8::gemm_phase<pg8::EpiResid, pg8::StaticOrder, true, true>(lds, g, S, E); } PH_END }
            if (f == 0) {
                const int mm = l * MODL + 3 * D;
                for (int rep = 0; rep < (PROBE_KIND == 4 ? 2 : 1); ++rep) {
                PH_BEGIN { pg8::Gemm g{H, WL + WL_WIN, M, NIN, D}; pg8::StaticOrder S; S.init(M, NIN, G, bx);
                    pg8::EpiMix E{(bf16*)(ws + WS_U), (bf16*)(ws + WS_QKVR), (float*)(ws + WS_LA), args.in[I_BGATE] + l * 256, SSQ, CB + (size_t)(l * 2) * CBROWS + CB_J1};
                    pg8::gemm_phase<pg8::EpiMix, pg8::StaticOrder, true, true>(lds, g, S, E); } PH_END }
                if (PROBE_KIND == 12) { PH_BEGIN { for (int u = vcu; u < 512; u += G) conv_unit(args, l, u, lds, tid, wave, lane); } PH_END }
                if (PROBE_KIND == 13) { PH_BEGIN { for (int u = vcu; u < 256; u += G) gla_p1_unit(args, u, lds, tid, wave, lane); } PH_END }
                for (int rep = 0; rep < (PROBE_KIND == 5 ? 2 : 1); ++rep) {
                PH_BEGIN { for (int u = vcu; u < 512; u += G) conv_unit(args, l, u, lds, tid, wave, lane);
                           for (int u = vcu; u < 256; u += G) gla_p1_unit(args, u, lds, tid, wave, lane); } PH_END
                PH_BEGIN gla_scan2(args, G, tid); PH_END
                if (PROBE_KIND == 14) { PH_BEGIN gla_scan2(args, G, tid); PH_END }
                PH_BEGIN { for (int u = vcu; u < 256; u += G) gla_p2_unit(args, l, u, lds, tid, wave, lane); } PH_END
                if (PROBE_KIND == 15) { PH_BEGIN { for (int u = vcu; u < 256; u += G) gla_p2_unit(args, l, u, lds, tid, wave, lane); } PH_END } }
                for (int rep = (PROBE_KIND == 8 ? 0 : 1); rep < 2; ++rep) {
                PH_BEGIN { pg8::Gemm g{Y, WL + WL_WOUT, M, D, D}; pg8::StaticOrder S; S.init(M, D, G, bx);
                    pg8::EpiResid E{X, rep == 0 ? (float*)(ws + WS_ACT) : X, MOD + mm + 2 * D, H, GS + (size_t)((l * 3 + 2) * 2) * D, (float*)(ws + WS_SSQ), D, 1.0f};
                    pg8::gemm_phase<pg8::EpiResid, pg8::StaticOrder, true, true>(lds, g, S, E); } PH_END }
            }
        }
    }
    PH_BEGIN final_phase(X, args.in[I_GFIN], MOD, gw, NGW, lane); PH_END
#undef PH_BEGIN
#undef PH_END
}

extern "C" void kernel_launch(void* const* d_in, const int* in_sizes, int n_in, void* d_out, int out_size, void* d_ws, size_t ws_size, hipStream_t stream) {
    static int grid = 0;
    if (grid == 0) {
        if (n_in != 23 || in_sizes[0] != M * D || out_size != M * D || ws_size < WS_END) { fprintf(stderr, "kernel_launch: unexpected shapes (n_in %d, in0 %d, out %d, ws %zu)\n", n_in, n_in > 0 ? in_sizes[0] : -1, out_size, ws_size); grid = -1; return; }
        int dev = 0, cus = 0, per_cu = 0;
        if (hipGetDevice(&dev) != hipSuccess || hipDeviceGetAttribute(&cus, hipDeviceAttributeMultiprocessorCount, dev) != hipSuccess) { grid = -1; return; }
        if (hipFuncSetAttribute((const void*)fwd_kernel, hipFuncAttributeMaxDynamicSharedMemorySize, LDS_BYTES) != hipSuccess) { fprintf(stderr, "kernel_launch: hipFuncSetAttribute failed\n"); grid = -1; return; }
        if (hipOccupancyMaxActiveBlocksPerMultiprocessor(&per_cu, (const void*)fwd_kernel, 512, LDS_BYTES) != hipSuccess || per_cu < 1) fprintf(stderr, "kernel_launch: occupancy query reports %d\n", per_cu);
        (void)hipGetLastError();
        grid = cus;
    }
    if (grid < 0) return;
    if (hipMemsetAsync((char*)d_ws + WS_CTL, 0, CTL_ZERO_BYTES, stream) != hipSuccess) return;
    Args a{};
    for (int i = 0; i < 23; ++i) a.in[i] = (const float*)d_in[i];
    a.out = (float*)d_out; a.ws = (unsigned char*)d_ws;
    if (N_LAUNCH_MODE == 0) { a.ph_lo = 0; a.ph_hi = NPHASES; hipLaunchKernelGGL(fwd_kernel, dim3(grid), dim3(512), LDS_BYTES, stream, a); }
    else for (int p = 0; p < NPHASES; ++p) { a.ph_lo = p; a.ph_hi = p + 1; hipLaunchKernelGGL(fwd_kernel, dim3(grid), dim3(512), LDS_BYTES, stream, a); }
}
```
